# Optimizing an MI355X kernel written in HIP

```python
import jax, jax.numpy as jnp
from jax import lax
import numpy as np

D_MODEL = 1024
BATCH = 16
SEQ = 256
DEPTH = 4
DEC_BATCH = 2
DEC_SEQ = 2048
PAST_LEN = 512

GRID_W = 64
N_MIXERS = 2
N_GLA_LAYERS = (DEPTH + N_MIXERS - 1) // N_MIXERS
N_FNET_LAYERS = DEPTH // N_MIXERS
GLA_HEADS = 4
GLA_QK = D_MODEL // 2
GLA_V = D_MODEL
GLA_DK = GLA_QK // GLA_HEADS
GLA_DV = GLA_V // GLA_HEADS
GATE_RANK = 16
GATE_TAU = 16.0
CHUNK = 64
GLA_IN = 2 * GLA_QK + 2 * GLA_V + 2 * GATE_RANK
FNET_GROUPS = 4
FNET_GW = D_MODEL // FNET_GROUPS
FFN_DIM = 2816
CONV_W = 3
EPS = 1e-6

kernel_name = "hybrid_gla_fnet_diffusion_step"


def rmsnorm(x, g):
    xf = x.astype(jnp.float32)
    y = xf * lax.rsqrt(jnp.mean(xf * xf, axis=-1, keepdims=True) + EPS)
    return (y * g.astype(jnp.float32)).astype(x.dtype)


def ada_mod(cvec, w, b):
    m = jax.nn.silu(cvec) @ w + b
    return jnp.split(m[:, None, :], 6, axis=-1)


def gla_chunked(q, k, v, logg, s0):
    B, L, H, DK = q.shape
    DV = v.shape[-1]
    nc = L // CHUNK

    def to_chunks(t):
        return t.astype(jnp.float32).reshape(B, nc, CHUNK, H, t.shape[-1]).transpose(1, 0, 3, 2, 4)

    qc, kc, vc, gc = to_chunks(q), to_chunks(k), to_chunks(v), to_chunks(logg)
    lower = jnp.tril(jnp.ones((CHUNK, CHUNK), dtype=bool))

    def step(state, inp):
        qi, ki, vi, gi = inp
        bcum = jnp.cumsum(gi, axis=2)
        diff = bcum[:, :, :, None, :] - bcum[:, :, None, :, :]
        decay = jnp.exp(jnp.where(lower[:, :, None], diff, -jnp.inf))
        attn = jnp.einsum('bhik,bhjk,bhijk->bhij', qi, ki, decay)
        o = (jnp.einsum('bhij,bhjv->bhiv', attn, vi)
             + jnp.einsum('bhik,bhkv->bhiv', qi * jnp.exp(bcum), state))
        b_last = bcum[:, :, -1:, :]
        state = (jnp.exp(b_last[:, :, 0, :])[..., None] * state
                 + jnp.einsum('bhjk,bhjv->bhkv', ki * jnp.exp(b_last - bcum), vi))
        return state, o

    s_fin, o = lax.scan(step, s0.astype(jnp.float32), (qc, kc, vc, gc))
    o = o.transpose(1, 0, 3, 2, 4).reshape(B, L, H, DV)
    return o, s_fin


def gla_mixer(h, w_in, w_g2, b_g, norm_g, w_o, s0_f, s0_b):
    B, L, _ = h.shape
    p = h @ w_in
    q, k, v, r, glr = jnp.split(p, [GLA_QK, 2 * GLA_QK, 2 * GLA_QK + GLA_V, 2 * GLA_QK + 2 * GLA_V], axis=-1)
    q = q.reshape(B, L, GLA_HEADS, GLA_DK) * (GLA_DK ** -0.5)
    k = k.reshape(B, L, GLA_HEADS, GLA_DK)
    v = v.reshape(B, L, GLA_HEADS, GLA_DV)
    glr = glr.reshape(B, L, 2, GATE_RANK)
    logit = jnp.einsum('blzr,zrk->blzk', glr, w_g2) + b_g
    logg = (jax.nn.log_sigmoid(logit.astype(jnp.float32)) / GATE_TAU).reshape(B, L, 2, GLA_HEADS, GLA_DK)
    o_f, s_f = gla_chunked(q, k, v, logg[:, :, 0], s0_f)
    o_b, s_b = gla_chunked(jnp.flip(q, 1), jnp.flip(k, 1), jnp.flip(v, 1), jnp.flip(logg[:, :, 1], 1), s0_b)
    o = (o_f + jnp.flip(o_b, 1)).astype(h.dtype)
    o = rmsnorm(o, norm_g) * jax.nn.silu(r.reshape(B, L, GLA_HEADS, GLA_DV))
    return o.reshape(B, L, GLA_V) @ w_o, s_f, s_b


def fourier_mixer(h, w_in, w_o):
    B, L, _ = h.shape
    u = (h @ w_in).reshape(B, L, FNET_GROUPS, FNET_GW).astype(jnp.float32)
    f = jnp.fft.fftn(u, axes=(1, 3), norm='ortho').real
    return f.astype(h.dtype).reshape(B, L, D_MODEL) @ w_o


def dwconv3(a, w, b):
    ap = jnp.pad(a, [(0, 0)] * (a.ndim - 2) + [(1, 1), (0, 0)])
    return ap[..., :-2, :] * w[0] + ap[..., 1:-1, :] * w[1] + ap[..., 2:, :] * w[2] + b


def conv_ffn(h, w_up, conv_w, conv_b, w_down, rows):
    B, L, _ = h.shape
    a, g = jnp.split(h @ w_up, 2, axis=-1)
    if rows is None:
        a = dwconv3(a, conv_w, conv_b)
    else:
        a = dwconv3(a.reshape(B, rows, GRID_W, FFN_DIM), conv_w, conv_b).reshape(B, L, FFN_DIM)
    return (jax.nn.silu(a) * g) @ w_down


def setup_inputs(seed: int = 0) -> dict:
    key = jax.random.key(seed)
    ks = jax.random.split(key, 24)
    f32 = jnp.float32
    nrm = lambda k, shape, s: jax.random.normal(k, shape, f32) * s
    D = D_MODEL
    return {
        'x_prompt': nrm(ks[0], (BATCH, SEQ, D), 1.0),
        'x_sample': nrm(ks[1], (DEC_BATCH, DEC_SEQ, D), 1.0),
        'state_gla': nrm(ks[2], (DEC_BATCH, N_GLA_LAYERS, 2, GLA_HEADS, GLA_DK, GLA_DV), 0.5),
        'c': nrm(ks[3], (DEC_BATCH, D), 1.0),
        'c_ctx': nrm(ks[4], (D,), 1.0),
        'norm_mix_g': 1.0 + nrm(ks[5], (DEPTH, D), 0.02),
        'norm_ffn_g': 1.0 + nrm(ks[6], (DEPTH, D), 0.02),
        'w_mod': nrm(ks[7], (DEPTH, D, 6 * D), 0.5 * D ** -0.5),
        'b_mod': nrm(ks[8], (DEPTH, 6 * D), 0.02),
        'gla_w_in': nrm(ks[9], (N_GLA_LAYERS, D, GLA_IN), D ** -0.5),
        'gla_w_g2': nrm(ks[10], (N_GLA_LAYERS, 2, GATE_RANK, GLA_QK), GATE_RANK ** -0.5),
        'gla_b_g': nrm(ks[11], (N_GLA_LAYERS, 2, GLA_QK), 0.1),
        'gla_norm_g': 1.0 + nrm(ks[12], (N_GLA_LAYERS, GLA_DV), 0.02),
        'gla_w_o': nrm(ks[13], (N_GLA_LAYERS, GLA_V, D), GLA_V ** -0.5),
        'fnet_w_in': nrm(ks[14], (N_FNET_LAYERS, D, D), D ** -0.5),
        'fnet_w_o': nrm(ks[15], (N_FNET_LAYERS, D, D), D ** -0.5),
        'ffn_w_up': nrm(ks[16], (DEPTH, D, 2 * FFN_DIM), D ** -0.5),
        'ffn_conv_w': nrm(ks[17], (DEPTH, CONV_W, FFN_DIM), CONV_W ** -0.5),
        'ffn_conv_b': nrm(ks[18], (DEPTH, FFN_DIM), 0.02),
        'ffn_w_down': nrm(ks[19], (DEPTH, FFN_DIM, D), FFN_DIM ** -0.5),
        'final_norm_g': 1.0 + nrm(ks[20], (D,), 0.02),
    }


def reference(x_prompt, x_sample, state_gla, c, c_ctx, norm_mix_g, norm_ffn_g, w_mod, b_mod,
              gla_w_in, gla_w_g2, gla_b_g, gla_norm_g, gla_w_o, fnet_w_in, fnet_w_o,
              ffn_w_up, ffn_conv_w, ffn_conv_b, ffn_w_down, final_norm_g):
    ctx = x_prompt
    lat = x_sample
    bsz = ctx.shape[0]
    rows = lat.shape[1] // GRID_W
    zero_state = jnp.zeros((bsz, GLA_HEADS, GLA_DK, GLA_DV), jnp.float32)
    new_states = []
    for i in range(DEPTH):
        sh1c, sc1c, gt1c, sh2c, sc2c, gt2c = ada_mod(c_ctx[None, :], w_mod[i], b_mod[i])
        sh1l, sc1l, gt1l, sh2l, sc2l, gt2l = ada_mod(c, w_mod[i], b_mod[i])
        hc = rmsnorm(ctx, norm_mix_g[i]) * (1 + sc1c) + sh1c
        hl = rmsnorm(lat, norm_mix_g[i]) * (1 + sc1l) + sh1l
        if i % N_MIXERS == 0:
            j = i // N_MIXERS
            yc, s_f, s_b = gla_mixer(hc, gla_w_in[j], gla_w_g2[j], gla_b_g[j], gla_norm_g[j], gla_w_o[j],
                                     zero_state, zero_state)
            new_states.append(jnp.stack([s_f, s_b], axis=1).astype(ctx.dtype))
            yl, _, _ = gla_mixer(hl, gla_w_in[j], gla_w_g2[j], gla_b_g[j], gla_norm_g[j], gla_w_o[j],
                                 state_gla[:, j, 0], state_gla[:, j, 1])
        else:
            j = i // N_MIXERS
            yc = fourier_mixer(hc, fnet_w_in[j], fnet_w_o[j])
            yl = fourier_mixer(hl, fnet_w_in[j], fnet_w_o[j])
        ctx = ctx + gt1c * yc
        lat = lat + gt1l * yl
        hc = rmsnorm(ctx, norm_ffn_g[i]) * (1 + sc2c) + sh2c
        hl = rmsnorm(lat, norm_ffn_g[i]) * (1 + sc2l) + sh2l
        ctx = ctx + gt2c * conv_ffn(hc, ffn_w_up[i], ffn_conv_w[i], ffn_conv_b[i], ffn_w_down[i], None)
        lat = lat + gt2l * conv_ffn(hl, ffn_w_up[i], ffn_conv_w[i], ffn_conv_b[i], ffn_w_down[i], rows)
    y_prompt = rmsnorm(ctx, final_norm_g)
    y_sample = rmsnorm(lat, final_norm_g)
    new_state_gla = jnp.stack(new_states, axis=1)
    return (y_prompt, y_sample, new_state_gla)
```

```cpp
#include <hip/hip_runtime.h>
#include <hip/hip_cooperative_groups.h>
#include <cstdio>
#include <cstdint>
namespace cg = cooperative_groups;

#ifndef REP_MASK
#define REP_MASK 0
#endif
#ifndef ONE_LAUNCH
#define ONE_LAUNCH 1
#endif

#define LAS __attribute__((address_space(3)))
typedef unsigned short bf16_t;
typedef short bf16x8 __attribute__((ext_vector_type(8)));
typedef float f32x4 __attribute__((ext_vector_type(4)));
typedef unsigned u32x4 __attribute__((ext_vector_type(4)));
typedef unsigned u32x2 __attribute__((ext_vector_type(2)));

#define LAUNDER_TID() ({ int _t = (g_wid << 6) | (int)__builtin_amdgcn_mbcnt_hi(~0u, __builtin_amdgcn_mbcnt_lo(~0u, 0u)); asm volatile("" : "+v"(_t)); _t; })
#define LAUNDER_BLK() ({ int _b = blockIdx.x; asm volatile("" : "+s"(_b)); _b; })
#define LAUNDER_PTR(x) ({ size_t _z = 0; asm volatile("" : "+s"(_z)); (x) + _z; })
constexpr int D = 1024, NTOK = 8192, NCTX = 4096, FFN = 2816, GIN = 3104, GINP = 3328;
constexpr int NT = 512;
constexpr size_t MB = 1024 * 1024;
constexpr size_t WS_CTL = 0, WS_MODV = 64 * 1024, WS_X = 1 * MB, WS_H = 33 * MB, WS_WGIN = 49 * MB, WS_WGO = 62 * MB, WS_WINB = 66 * MB,
                 WS_WOT = 70 * MB, WS_T1 = 74 * MB, WS_WCS = 82 * MB, WS_WUP = 90 * MB, WS_WDN = 134 * MB, WS_CW = 156 * MB, WS_DL256 = 157 * MB,
                 WS_DL2048 = 159 * MB, WS_S = 175 * MB, WS_END = 325 * MB;
constexpr size_t S_UPA = 0, S_UPG = 44 * MB, S_ACT = 88 * MB, S_PART = 0, S_Q = 0, S_K = 8 * MB, S_V = 16 * MB, S_R = 32 * MB, S_GLR = 48 * MB,
                 S_QF = 49 * MB, S_KF = 57 * MB, S_QB = 65 * MB, S_KB = 73 * MB, S_KFT = 81 * MB, S_KBT = 89 * MB, S_VT = 97 * MB, S_EE = 113 * MB,
                 S_OF = 114 * MB, S_OB = 130 * MB, S_HWTC = 80 * MB, S_HWTL = 96 * MB;
constexpr size_t PART_STRIDE = (size_t)NTOK * D;
constexpr int LDS_STAGE = 131072, LDS_TOP = 152576  , LDS_XB = LDS_TOP + 256  , LDS_BYTES = LDS_XB + 4096;

struct Params {
    const float *x_prompt, *x_sample, *state_gla, *c, *c_ctx, *norm_mix_g, *norm_ffn_g, *w_mod, *b_mod, *gla_w_in, *gla_w_g2, *gla_b_g, *gla_norm_g,
        *gla_w_o, *fnet_w_in, *fnet_w_o, *ffn_w_up, *ffn_conv_w, *ffn_conv_b, *ffn_w_down, *final_norm_g;
    float* out; unsigned char* ws; int ph_lo, ph_hi, never, pad;
};

typedef __bf16 bf16v2_t __attribute__((ext_vector_type(2)));
typedef float f32v2_t __attribute__((ext_vector_type(2)));
__device__ __forceinline__ unsigned cvt_pk_bf16(float lo, float hi) { const f32v2_t v = {lo, hi}; const bf16v2_t b = __builtin_convertvector(v, bf16v2_t); return __builtin_bit_cast(unsigned, b); }
__device__ __forceinline__ bf16_t f2bf(float f) { return (bf16_t)(cvt_pk_bf16(f, 0.f) & 0xffffu); }
__device__ __forceinline__ float bf_lo(unsigned u) { return __uint_as_float(u << 16); }
__device__ __forceinline__ float bf_hi(unsigned u) { return __uint_as_float(u & 0xffff0000u); }
__device__ __forceinline__ float bf2f(bf16_t b) { return __uint_as_float(((unsigned)b) << 16); }
__device__ __forceinline__ float silu_f(float x) { return x / (1.f + __expf(-x)); }

#define XB_TMO      128
#define XB_XCNT(j)  (256  + 64 * (j))
#define XB_XSUB(j)  (1280 + 64 * (j))
#define XB_XGEN(j)  (2304 + 64 * (j))
#define XB_TOP      3328
#define XB_TOPGEN   3392
#define XCD_BAR_WORDS 3456
#define XB_SPIN_CAP (1u << 20)
__device__ __forceinline__ unsigned xb_ld(unsigned* p)              { return __hip_atomic_load(p, __ATOMIC_RELAXED, __HIP_MEMORY_SCOPE_AGENT); }
__device__ __forceinline__ unsigned xb_add(unsigned* p, unsigned v) { return __hip_atomic_fetch_add(p, v, __ATOMIC_RELAXED, __HIP_MEMORY_SCOPE_AGENT); }
__device__ __forceinline__ unsigned xb_xcc_id() { return (unsigned)__builtin_amdgcn_s_getreg((3 << 11) | 20) & 0xFu; }
#define XB_SPIN(cond, bar) do { unsigned _sp = 0; while (cond) { __builtin_amdgcn_s_sleep(1); \
    if ((++_sp & 255u) == 0u) { if (xb_ld(&(bar)[XB_TMO])) break; if (_sp > XB_SPIN_CAP) { atomicAdd(&(bar)[XB_TMO], 1u); break; } } } } while (0)
struct XcdBarrier { unsigned* bar; unsigned x; volatile LAS unsigned* st; };
__device__ __forceinline__ XcdBarrier xcd_barrier_post(unsigned* bar, volatile LAS unsigned* st) {
    XcdBarrier b; b.bar = bar; b.x = xb_xcc_id(); b.st = st;
    if (threadIdx.x == 0) (void)xb_add(&bar[XB_XCNT(b.x)], 1u);
    return b;
}
__device__ __forceinline__ void xcd_barrier_complete(unsigned* bar, unsigned x, unsigned& nloc, unsigned& nx) {
    const unsigned G = gridDim.x * gridDim.y * gridDim.z;
    unsigned sum, cnt, mine, sp = 0u;
    for (;;) {
        sum = 0u; cnt = 0u; mine = 0u;
#pragma unroll
        for (unsigned j = 0; j < 16; ++j) { const unsigned c = xb_ld(&bar[XB_XCNT(j)]); sum += c; cnt += (c > 0u) ? 1u : 0u; mine = (j == x) ? c : mine; }
        if (sum == G) break;
        __builtin_amdgcn_s_sleep(1);
        if ((++sp & 255u) == 0u) { if (xb_ld(&bar[XB_TMO])) break; if (sp > XB_SPIN_CAP) { atomicAdd(&bar[XB_TMO], 1u); break; } }
    }
    nloc = mine > 0u ? mine : 1u; nx = cnt > 0u ? cnt : 1u;
}
__device__ __forceinline__ void xcd_barrier(const int g_wid, const XcdBarrier& b) {
    asm volatile("s_waitcnt vmcnt(0)" ::: "memory");
    __syncthreads();
    if (LAUNDER_TID() == 0) {
        unsigned* bar = b.bar;
        __builtin_amdgcn_s_waitcnt(0);
        unsigned nloc = b.st[0], nx = b.st[1];
        if (nloc == 0u) { xcd_barrier_complete(bar, b.x, nloc, nx); b.st[0] = nloc; b.st[1] = nx; }
        const unsigned old = xb_add(&bar[XB_XSUB(b.x)], 1u);
        const unsigned gen = old / nloc;
        if (old + 1u == (gen + 1u) * nloc) {
            __builtin_amdgcn_fence(__ATOMIC_RELEASE, "agent");
            asm volatile("s_waitcnt vmcnt(0)" ::: "memory");
            const unsigned og = xb_add(&bar[XB_TOP], 1u);
            const unsigned tg = og / nx;
            if (og + 1u == (tg + 1u) * nx) xb_add(&bar[XB_TOPGEN], 1u);
            else XB_SPIN(xb_ld(&bar[XB_TOPGEN]) == tg, bar);
            __builtin_amdgcn_fence(__ATOMIC_ACQUIRE, "agent");
            xb_add(&bar[XB_XGEN(b.x)], 1u);
            asm volatile("s_waitcnt vmcnt(0)" ::: "memory");
        } else {
            XB_SPIN(xb_ld(&bar[XB_XGEN(b.x)]) == gen, bar);
            __builtin_amdgcn_fence(__ATOMIC_ACQUIRE, "agent");
            asm volatile("s_waitcnt vmcnt(0)" ::: "memory");
        }
    }
    __syncthreads();
}

namespace pg8 {
constexpr int BM = 256, BK = 64, HALF = 128, HTB = HALF * BK * 2, NXCD = 8, WGM = 8;
__device__ __forceinline__ int lds_byte(int r, int c) { const int st = (r >> 4) * 2 + (c >> 5), rr = r & 15, cc = c & 31, ob = rr * 64 + cc * 2; return st * 1024 + (ob ^ (((ob >> 9) & 1) << 5)); }
__device__ __forceinline__ void stage_rc(int b, int& R, int& C) { const int st = b / 1024, sb = b % 1024, swz = sb ^ (((sb >> 9) & 1) << 5); R = (st >> 1) * 16 + swz / 64; C = (st & 1) * 32 + (swz % 64) / 2; }
__device__ __forceinline__ int perm32(int rho) { const int n = rho >> 4, i = rho & 15; return 8 * (i >> 2) + 4 * n + (i & 3); }
struct Unit { const char* A; const char* B; bf16_t* dst; int nt; int ldo; float scale; int f32; int cch; };
__device__ __forceinline__ bool tile_order(long L, int nM, int nN, int& pm, int& pn) {
    const int nwg = nM * nN; if (L >= nwg) return false;
    int wgid = (int)L; { const int q = nwg / NXCD, r = nwg % NXCD, xcd = wgid % NXCD, off = wgid / NXCD; wgid = (xcd < r ? xcd * (q + 1) : r * (q + 1) + (xcd - r) * q) + off; }
    const int nig = WGM * nN, gid = wgid / nig, fm = gid * WGM, gsz = (nM - fm) < WGM ? (nM - fm) : WGM;
    pm = fm + ((wgid % nig) % gsz); pn = (wgid % nig) / gsz; return true;
}
__device__ __forceinline__ float dpp_ror1(float v) { return __builtin_bit_cast(float, __builtin_amdgcn_mov_dpp(__builtin_bit_cast(int, v), 0x121, 0xf, 0xf, true)); }
__device__ __forceinline__ float dpp_rol1(float v) { return __builtin_bit_cast(float, __builtin_amdgcn_mov_dpp(__builtin_bit_cast(int, v), 0x12F, 0xf, 0xf, true)); }
__device__ __forceinline__ void run_epi_glu(const f32x4 (&acc)[2][2][4][2], const Unit& u, int wr, int wc, int fr, const int fq, const float* cw, const float* cb, LAS float* xb) {
    int cl = wc * 32 + 8 * fq;
    asm volatile("" : "+v"(cl), "+v"(fr));
    const bool ctx = u.f32 == 3;
    if (ctx) {
#pragma unroll
        for (int ai = 0; ai < 2; ++ai) { const int ci = 2 * ai + wr;
            if (fr == 0) { *(LAS f32x4*)(xb + (ci * 2 + 0) * 128 + cl) = acc[ai][0][0][0]; *(LAS f32x4*)(xb + (ci * 2 + 0) * 128 + cl + 4) = acc[ai][0][0][1]; }
            if (fr == 15) { *(LAS f32x4*)(xb + (ci * 2 + 1) * 128 + cl) = acc[ai][0][3][0]; *(LAS f32x4*)(xb + (ci * 2 + 1) * 128 + cl + 4) = acc[ai][0][3][1]; } }
        asm volatile("s_waitcnt lgkmcnt(0)" ::: "memory");
        __builtin_amdgcn_s_barrier();
        asm volatile("" ::: "memory");
        __builtin_amdgcn_s_barrier();
        asm volatile("" ::: "memory");
    }
    bf16_t* base = u.dst + (size_t)(wr * 64 + fr) * FFN + cl;
#pragma unroll
    for (int h = 0; h < 2; ++h) {
        const int c = u.cch + cl + 4 * h;
        const f32x4 w0 = *(const f32x4*)(cw + c), w1 = *(const f32x4*)(cw + FFN + c), w2 = *(const f32x4*)(cw + 2 * FFN + c), bb = *(const f32x4*)(cb + c);
#pragma unroll
        for (int ai = 0; ai < 2; ++ai) {
            const int ci = 2 * ai + wr;
            f32x4 top = {0.f, 0.f, 0.f, 0.f}, bot = {0.f, 0.f, 0.f, 0.f};
            if (ctx) {
                if (ci > 0) top = *(const LAS f32x4*)(xb + ((ci - 1) * 2 + 1) * 128 + cl + 4 * h);
                if (ci < 3) bot = *(const LAS f32x4*)(xb + ((ci + 1) * 2 + 0) * 128 + cl + 4 * h);
            }
#pragma unroll
            for (int m = 0; m < 4; ++m) {
                float y[4];
#pragma unroll
                for (int x = 0; x < 4; ++x) {
                    const float cur = acc[ai][0][m][h][x];
                    const float upv = (m > 0) ? dpp_ror1(acc[ai][0][m > 0 ? m - 1 : 0][h][x]) : top[x];
                    const float dnv = (m < 3) ? dpp_rol1(acc[ai][0][m < 3 ? m + 1 : 3][h][x]) : bot[x];
                    const float prev = __builtin_bit_cast(float, __builtin_amdgcn_update_dpp(__builtin_bit_cast(int, upv), __builtin_bit_cast(int, cur), 0x111, 0xf, 0xf, false));
                    const float next = __builtin_bit_cast(float, __builtin_amdgcn_update_dpp(__builtin_bit_cast(int, dnv), __builtin_bit_cast(int, cur), 0x101, 0xf, 0xf, false));
                    const float v = prev * w0[x] + cur * w1[x] + next * w2[x] + bb[x];
                    y[x] = v * __builtin_amdgcn_rcpf(1.f + __expf(-v)) * acc[ai][1][m][h][x];
                }
                u32x2 o; o[0] = cvt_pk_bf16(y[0], y[1]); o[1] = cvt_pk_bf16(y[2], y[3]);
                *(u32x2*)(base + (size_t)(ai * HALF + m * 16) * FFN + 4 * h) = o;
            }
        }
    }
    if (ctx) asm volatile("s_waitcnt lgkmcnt(0)" ::: "memory");
}
__device__ __forceinline__ void run_epi(const f32x4 (&acc)[2][2][4][2], const Unit& u, int wr, int wc, int fr, int fq) {
    const float s = u.scale;
    if (u.f32) {
        if (wc == 0) {
#pragma unroll
            for (int ai = 0; ai < 2; ++ai)
#pragma unroll
                for (int m = 0; m < 4; ++m) { float* d = (float*)u.dst + (size_t)(ai * HALF + wr * 64 + m * 16 + fr) * 32 + 8 * fq; *(f32x4*)d = acc[ai][0][m][0]; *(f32x4*)(d + 4) = acc[ai][0][m][1]; }
        }
        return;
    }
    const __amdgpu_buffer_rsrc_t rs = __builtin_amdgcn_make_buffer_rsrc((void*)u.dst, (short)0, 0x7FFFFFF0, 0x00020000);
    const unsigned ldb2 = (unsigned)u.ldo * 2u;
    const unsigned boff = (unsigned)(wr * 64 + fr) * ldb2 + (unsigned)(wc * 32 + 8 * fq) * 2u;
#pragma unroll
    for (int ai = 0; ai < 2; ++ai)
#pragma unroll
        for (int m = 0; m < 4; ++m)
#pragma unroll
            for (int bj = 0; bj < 2; ++bj) { const f32x4 v0 = acc[ai][bj][m][0], v1 = acc[ai][bj][m][1];
                u32x4 o; o[0] = cvt_pk_bf16(v0[0] * s, v0[1] * s); o[1] = cvt_pk_bf16(v0[2] * s, v0[3] * s); o[2] = cvt_pk_bf16(v1[0] * s, v1[1] * s); o[3] = cvt_pk_bf16(v1[2] * s, v1[3] * s);
                __builtin_amdgcn_raw_buffer_store_b128(o, rs, boff + (unsigned)(ai * HALF + m * 16) * ldb2 + (unsigned)(bj * HALF * 2), 0,   16); }
}
template <class Sched>
__device__ __forceinline__ void gemm_phase(const int g_wid, LAS unsigned char* lds, const int lda, const int ldb  , const Sched& S) {
    const int tid = LAUNDER_TID(), wid = __builtin_amdgcn_readfirstlane(tid >> 6), lane = tid & 63, wr = wid >> 2, wc = wid & 3, fr = lane & 15, fq = lane >> 4;
    unsigned voffA[2], voffB[2];
#pragma unroll
    for (int i = 0; i < 2; ++i) { int R, C; stage_rc(tid * 16 + i * 8192, R, C); const int Rb = (R & ~31) + perm32(R & 31);
        voffA[i] = (unsigned)(R * lda + C * 2); voffB[i] = (unsigned)(Rb * ldb + C * 2); }
    const size_t kstep = (size_t)(BK * 2);
    const size_t hstepA = (size_t)HALF * lda, hstepB = (size_t)HALF * ldb;
    const unsigned ldsw = (unsigned)wid * 1024u;
    const int aoff = lds_byte(wr * 64 + fr, fq * 8), boff = lds_byte(wc * 32 + fr, fq * 8);
#define PG8_SA(b, h) (((b) * 2 + (h)) * HTB)
#define PG8_SB(b, h) ((4 + (b) * 2 + (h)) * HTB)
#define PG8_STAGE(bufoff, gbase, voff) do { _Pragma("unroll") for (int _i = 0; _i < 2; ++_i) \
        __builtin_amdgcn_global_load_lds((const unsigned*)((const char*)(gbase) + (voff)[_i]), (LAS unsigned*)(lds + (bufoff) + ldsw + _i * 8192), 16, 0, 0); } while (0)
#define PG8_LDA(dst, b, h) do { _Pragma("unroll") for (int m = 0; m < 4; ++m) _Pragma("unroll") for (int k = 0; k < 2; ++k) dst[m][k] = *(const LAS bf16x8*)(lds + PG8_SA(b, h) + aoff + m * 2048 + k * 1024); } while (0)
#define PG8_LDB(dst, b, h) do { _Pragma("unroll") for (int n = 0; n < 2; ++n) _Pragma("unroll") for (int k = 0; k < 2; ++k) dst[n][k] = *(const LAS bf16x8*)(lds + PG8_SB(b, h) + boff + n * 2048 + k * 1024); } while (0)
#define PG8_MMA(ai, bj, At, Bt) do { __builtin_amdgcn_s_setprio(1); _Pragma("unroll") for (int m = 0; m < 4; ++m) _Pragma("unroll") for (int n = 0; n < 2; ++n) _Pragma("unroll") for (int k = 0; k < 2; ++k) \
        acc[ai][bj][m][n] = __builtin_amdgcn_mfma_f32_16x16x32_bf16(Bt[n][k], At[m][k], acc[ai][bj][m][n], 0, 0, 0); __builtin_amdgcn_s_setprio(0); } while (0)
#define PG8_WAIT_V(n) asm volatile("s_waitcnt vmcnt(" #n ")" ::: "memory")
#define PG8_WAIT_L(n) asm volatile("s_waitcnt lgkmcnt(" #n ")" ::: "memory")
#define PG8_BAR __builtin_amdgcn_s_barrier()
#define PG8_SCHED __builtin_amdgcn_sched_barrier(0)
    Unit cur, nxt; int ui = 0;
    if (!S.next(0, cur)) return;
    f32x4 acc[2][2][4][2];
#pragma unroll
    for (int a = 0; a < 2; ++a)
#pragma unroll
        for (int b = 0; b < 2; ++b)
#pragma unroll
            for (int m = 0; m < 4; ++m)
#pragma unroll
                for (int n = 0; n < 2; ++n) acc[a][b][m][n] = (f32x4){0.f, 0.f, 0.f, 0.f};
    bf16x8 At[4][2], B0[2][2], B1[2][2];
    const char* cA = cur.A; const char* cB = cur.B;
    PG8_STAGE(PG8_SB(0, 0), cB, voffB); PG8_STAGE(PG8_SA(0, 0), cA, voffA); PG8_STAGE(PG8_SB(0, 1), cB + hstepB, voffB); PG8_STAGE(PG8_SA(0, 1), cA + hstepA, voffA);
    if (wr == 1) PG8_BAR;
    PG8_WAIT_V(4); PG8_BAR;
    PG8_STAGE(PG8_SB(1, 0), cB + kstep, voffB); PG8_STAGE(PG8_SA(1, 0), cA + kstep, voffA); PG8_STAGE(PG8_SB(1, 1), cB + hstepB + kstep, voffB);
    PG8_WAIT_V(6); PG8_BAR;
    for (;;) {
        const bool has_next = S.next(ui + 1, nxt);
        const char* nA = has_next ? nxt.A : cA; const char* nB = has_next ? nxt.B : cB;
        const int nt = cur.nt;
        for (int t = 0; t < nt; t += 2) {
            const bool last = (t == nt - 2);
            const char* a1 = cA + (size_t)(t + 1) * kstep;
            const char* a2 = last ? nA : cA + (size_t)(t + 2) * kstep; const char* b2 = last ? nB : cB + (size_t)(t + 2) * kstep;
            const char* a3 = a2 + kstep; const char* b3 = b2 + kstep;
            PG8_LDB(B0, 0, 0); PG8_SCHED; PG8_LDA(At, 0, 0); PG8_STAGE(PG8_SA(1, 1), a1 + hstepA, voffA);
            PG8_WAIT_L(8); PG8_BAR; PG8_WAIT_L(0); PG8_MMA(0, 0, At, B0); PG8_BAR; PG8_SCHED;
            PG8_LDB(B1, 0, 1); PG8_STAGE(PG8_SB(0, 0), b2, voffB);
            PG8_BAR; PG8_WAIT_L(0); PG8_MMA(0, 1, At, B1); PG8_BAR;
            PG8_LDA(At, 0, 1); PG8_STAGE(PG8_SA(0, 0), a2, voffA);
            PG8_BAR; PG8_WAIT_L(0); PG8_MMA(1, 0, At, B0); PG8_BAR; PG8_SCHED;
            PG8_STAGE(PG8_SB(0, 1), b2 + hstepB, voffB);
            PG8_WAIT_V(6); PG8_BAR; PG8_MMA(1, 1, At, B1); PG8_BAR;
            PG8_LDB(B0, 1, 0); PG8_SCHED; PG8_LDA(At, 1, 0); PG8_STAGE(PG8_SA(0, 1), a2 + hstepA, voffA);
            PG8_WAIT_L(8); PG8_BAR; PG8_WAIT_L(0); PG8_MMA(0, 0, At, B0); PG8_BAR; PG8_SCHED;
            PG8_LDB(B1, 1, 1); PG8_STAGE(PG8_SB(1, 0), b3, voffB);
            PG8_BAR; PG8_WAIT_L(0); PG8_MMA(0, 1, At, B1); PG8_BAR;
            PG8_LDA(At, 1, 1); PG8_STAGE(PG8_SA(1, 0), a3, voffA);
            PG8_BAR; PG8_WAIT_L(0); PG8_MMA(1, 0, At, B0); PG8_BAR; PG8_SCHED;
            PG8_STAGE(PG8_SB(1, 1), b3 + hstepB, voffB);
            PG8_WAIT_V(6); PG8_BAR; PG8_MMA(1, 1, At, B1); PG8_BAR;
        }
        if (wr == 0) PG8_BAR;
        if (cur.f32 >= 2) run_epi_glu(acc, cur, wr, wc, fr, fq, S.cw, S.cb, (LAS float*)(lds + LDS_XB)); else run_epi(acc, cur, wr, wc, fr, fq);
        if (!has_next) break;
        if (wr == 1) PG8_BAR;
#pragma unroll
        for (int a = 0; a < 2; ++a)
#pragma unroll
            for (int b = 0; b < 2; ++b)
#pragma unroll
                for (int m = 0; m < 4; ++m)
#pragma unroll
                    for (int n = 0; n < 2; ++n) acc[a][b][m][n] = (f32x4){0.f, 0.f, 0.f, 0.f};
        cur = nxt; cA = nA; cB = nB; ++ui;
    }
    PG8_WAIT_V(0);
    PG8_BAR;
#undef PG8_SA
#undef PG8_SB
#undef PG8_STAGE
#undef PG8_LDA
#undef PG8_LDB
#undef PG8_MMA
#undef PG8_WAIT_V
#undef PG8_WAIT_L
#undef PG8_BAR
#undef PG8_SCHED
}
}
using pg8::Unit;

struct GSched { int kind; const char* A; const char* B; const char* A2; const char* B2; bf16_t* o0; bf16_t* o1; const float* cw; const float* cb; int lda, ldb, nM, nN, nt, koff, G, c;
    __device__ __forceinline__ bool next(int i, Unit& u) const {
        u.scale = 1.f; u.f32 = 0; u.nt = nt; u.cch = 0;
        if (kind <= 2) { int pm, pn; if (!pg8::tile_order((long)i * G + c, nM, nN, pm, pn)) return false;
            u.A = A + (size_t)pm * 256 * lda; u.B = B + (size_t)pn * 256 * ldb;
            if (kind == 0) {
                if (pn < 2) { u.dst = (bf16_t*)((char*)o0 + S_Q) + (size_t)pm * 256 * 512 + pn * 256; u.ldo = 512; u.scale = 0.08838834764831845f; }
                else if (pn < 4) { u.dst = (bf16_t*)((char*)o0 + S_K) + (size_t)pm * 256 * 512 + (pn - 2) * 256; u.ldo = 512; }
                else if (pn < 8) { u.dst = (bf16_t*)((char*)o0 + S_V) + (size_t)pm * 256 * 1024 + (pn - 4) * 256; u.ldo = 1024; }
                else if (pn < 12) { u.dst = (bf16_t*)((char*)o0 + S_R) + (size_t)pm * 256 * 1024 + (pn - 8) * 256; u.ldo = 1024; }
                else { u.dst = (bf16_t*)((float*)((char*)o0 + S_GLR) + (size_t)pm * 256 * 32); u.ldo = 0; u.f32 = 1; } }
            else if (kind == 1) { u.ldo = FFN; u.dst = o0 + (size_t)pm * 256 * FFN + pn * 128; u.cch = pn * 128; u.f32 = pm < 16 ? 3 : 2; }
            else { const int cs = pm >> 2, n0 = (pm & 3) * 256; u.ldo = 8192;
                if (pn < 16) u.dst = o0 + (size_t)n0 * 8192 + pn * 512 + cs * 256;
                else { const int t0 = (pn - 16) * 256, b = t0 >> 11, l0 = t0 & 2047; u.dst = o1 + (size_t)n0 * 8192 + b * 4096 + cs * 2048 + l0; } }
            return true; }
        if (kind == 3) { int pm, p8; if (!pg8::tile_order((long)i * G + c, 32, 8, pm, p8)) return false; const int pn = p8 & 3, ks = p8 >> 2;
            u.A = A + (size_t)pm * 256 * lda + (size_t)ks * koff; u.B = B + (size_t)pn * 256 * ldb + (size_t)ks * koff;
            u.dst = o0 + (size_t)ks * PART_STRIDE + (size_t)pm * 256 * D + pn * 256; u.ldo = D; return true; }
        if (kind == 4) { const int id = i * G + c; if (id >= 64) return false; const int pm = id & 3, g = (id >> 2) & 3, cs = (id >> 4) & 1, layer = id >> 5;
            u.A = A + (size_t)layer * 2 * MB + (size_t)pm * 256 * 2048 + g * 512; u.B = B + (size_t)cs * 256 * 512;
            u.dst = o0 + (size_t)(id >> 4) * 1048576 + (size_t)pm * 256 * 1024 + g * 256; u.ldo = 1024; return true; }
        if (kind == 5) { const int id = i * G + c; if (id >= 64) return false; const int pn = id & 3, pm = (id >> 2) & 3, lc = id >> 4, layer = lc >> 1, cs = lc & 1;
            u.A = A + (size_t)layer * 2 * MB + (size_t)pm * 256 * 2048; u.B = B + (size_t)lc * 2 * MB + (size_t)pn * 256 * 2048;
            u.dst = o0 + (size_t)layer * 2097152 + (size_t)(cs * 1024 + pm * 256) * 1024 + pn * 256; u.ldo = 1024; return true; }
        {
            u.ldo = D;
            if (G != 256) {
                const int L = i * G + c; if (L >= 384) return false;
                if (L < 256) { const int ks = L & 3, pn = (L >> 2) & 3, pm = (L >> 4) & 7, b = L >> 7;
                    u.A = A + (size_t)pm * 256 * 8192 + ks * 2048; u.B = B + (size_t)pn * 256 * 16384 + (size_t)b * 8192 + ks * 2048; u.nt = 16;
                    u.dst = o0 + (size_t)ks * PART_STRIDE + (size_t)(NCTX + b * 2048 + pm * 256) * D + pn * 256; u.scale = 0.0013810679320049757f; return true; }
                const int id = L - 256, ks = id & 1, pn = (id >> 1) & 3, b = id >> 3;
                u.A = A2 + ks * 512; u.B = B2 + (size_t)pn * 256 * 16384 + (size_t)b * 1024 + ks * 512; u.nt = 4;
                u.dst = o0 + (size_t)ks * PART_STRIDE + (size_t)b * 256 * D + pn * 256; u.scale = 0.00390625f; return true; }
            if (i == 0) { const int id = c; if (id >= 256) return false; const int ks = id & 3, pn = (id >> 2) & 3, pm = (id >> 4) & 7, b = id >> 7;
                u.A = A + (size_t)pm * 256 * 8192 + ks * 2048; u.B = B + (size_t)pn * 256 * 16384 + (size_t)b * 8192 + ks * 2048; u.nt = 16;
                u.dst = o0 + (size_t)ks * PART_STRIDE + (size_t)(NCTX + b * 2048 + pm * 256) * D + pn * 256; u.scale = 0.0013810679320049757f; return true; }
            if (i == 1) { const int id = G - 1 - c; if (id >= 128) return false; const int ks = id & 1, pn = (id >> 1) & 3, b = id >> 3;
                u.A = A2 + ks * 512; u.B = B2 + (size_t)pn * 256 * 16384 + (size_t)b * 1024 + ks * 512; u.nt = 4;
                u.dst = o0 + (size_t)ks * PART_STRIDE + (size_t)b * 256 * D + pn * 256; u.scale = 0.00390625f; return true; }
            return false; }
    } };

__device__ void setup_phase(const int g_wid, const Params& p, LAS unsigned char* ldsb) {
    const int tid_l = LAUNDER_TID(), blk_l = LAUNDER_BLK(); unsigned char* const ws_l = LAUNDER_PTR(p.ws); (void)tid_l; (void)blk_l; (void)ws_l;
    LAS float* lf = (LAS float*)ldsb;
    const int tid = tid_l, blk = blk_l, G = gridDim.x;
    unsigned char* ws = ws_l;
    for (int job = blk; job < 256; job += G) {
        const int layer = job >> 6, col0 = (job & 63) * 96;
        for (int i = tid; i < 3072; i += NT) { const int v = i >> 10, k = i & 1023; const float x = (v == 0) ? p.c_ctx[k] : p.c[(v - 1) * 1024 + k]; lf[i] = silu_f(x); }
        __syncthreads();
        if (tid < 384) {
            const int cq = tid % 24, rg = tid / 24;
            f32x4 a0 = {0.f, 0.f, 0.f, 0.f}, a1 = a0, a2 = a0;
            const float* wp = p.w_mod + ((size_t)layer * 1024 + rg * 64) * 6144 + col0 + cq * 4;
#pragma unroll 32
            for (int k = 0; k < 64; ++k) { const f32x4 w = *(const f32x4*)(wp + (size_t)k * 6144); const int kk = rg * 64 + k;
                a0 += w * lf[kk]; a1 += w * lf[1024 + kk]; a2 += w * lf[2048 + kk]; }
            LAS float* red = lf + 3072;
#pragma unroll
            for (int e = 0; e < 4; ++e) { red[(rg * 3 + 0) * 96 + cq * 4 + e] = a0[e]; red[(rg * 3 + 1) * 96 + cq * 4 + e] = a1[e]; red[(rg * 3 + 2) * 96 + cq * 4 + e] = a2[e]; }
        }
        __syncthreads();
        if (tid < 288) { const int v = tid / 96, cc = tid % 96; float s = p.b_mod[layer * 6144 + col0 + cc];
            for (int rg = 0; rg < 16; ++rg) s += lf[3072 + (rg * 3 + v) * 96 + cc];
            ((float*)(ws + WS_MODV))[(layer * 3 + v) * 6144 + col0 + cc] = s; }
        __syncthreads();
    }
    {
        constexpr int T_GIN = 2 * 16 * 13, T_GO = 2 * 16 * 4, T_FO = 2 * 16 * 4, T_UP = 4 * 16 * 22, T_DN = 4 * 44 * 4, T_ALL = T_GIN + T_GO + T_FO + T_UP + T_DN;
        for (int job = blk; job < T_ALL; job += G) {
            const float* src; bf16_t* dst; int K, N, kt, ntile; int j = job; bool up = false;
            if (j < T_GIN) { const int l = j / (16 * 13); j %= 16 * 13; kt = j / 13; ntile = j % 13; K = 1024; N = GIN; src = p.gla_w_in + (size_t)l * 1024 * GIN; dst = (bf16_t*)(ws + WS_WGIN) + (size_t)l * GINP * 1024; }
            else if ((j -= T_GIN) < T_GO) { const int l = j / 64; j %= 64; kt = j / 4; ntile = j % 4; K = 1024; N = 1024; src = p.gla_w_o + (size_t)l * 1048576; dst = (bf16_t*)(ws + WS_WGO) + (size_t)l * 1048576; }
            else if ((j -= T_GO) < T_FO) { const int l = j / 64; j %= 64; kt = j / 4; ntile = j % 4; K = 1024; N = 1024; src = p.fnet_w_o + (size_t)l * 1048576; dst = (bf16_t*)(ws + WS_WOT) + (size_t)l * 1048576; }
            else if ((j -= T_FO) < T_UP) { const int l = j / (16 * 22); j %= 16 * 22; kt = j / 22; ntile = j % 22; up = true; K = 1024; N = 2 * FFN; src = p.ffn_w_up + (size_t)l * 1024 * 2 * FFN; dst = (bf16_t*)(ws + WS_WUP) + (size_t)l * 2 * FFN * 1024; }
            else { j -= T_UP; const int l = j / (44 * 4); j %= 44 * 4; kt = j / 4; ntile = j % 4; K = FFN; N = 1024; src = p.ffn_w_down + (size_t)l * FFN * 1024; dst = (bf16_t*)(ws + WS_WDN) + (size_t)l * 1024 * FFN; }
            const int k0 = kt * 64, n0 = ntile * 256;
            f32x4 wv[8];
#pragma unroll
            for (int u = 0; u < 8; ++u) { const int kr = (tid >> 6) + 8 * u, n = n0 + (tid & 63) * 4; wv[u] = (f32x4){0.f, 0.f, 0.f, 0.f}; if (n < N) wv[u] = *(const f32x4*)(src + (size_t)(k0 + kr) * N + n); }
#pragma unroll
            for (int u = 0; u < 8; ++u) { const int kr = (tid >> 6) + 8 * u;
#pragma unroll
                for (int e = 0; e < 4; ++e) lf[kr * 257 + (tid & 63) * 4 + e] = wv[u][e]; }
            __syncthreads();
            { const int n = tid >> 1, kh = tid & 1; int orow = n0 + n;
              if (up) { const int part = n0 >= FFN ? 1 : 0, ch = n0 + n - part * FFN; orow = (ch >> 7) * 256 + part * 128 + (ch & 127); }
#pragma unroll
              for (int c4 = 0; c4 < 4; ++c4) { u32x4 o;
#pragma unroll
                  for (int e = 0; e < 4; ++e) o[e] = cvt_pk_bf16(lf[(kh * 32 + c4 * 8 + 2 * e) * 257 + n], lf[(kh * 32 + c4 * 8 + 2 * e + 1) * 257 + n]);
                  *(u32x4*)(dst + (size_t)orow * K + k0 + kh * 32 + c4 * 8) = o; } }
            __syncthreads();
        }
    }
    const size_t gt = (size_t)blk * NT + tid, gs = (size_t)G * NT;
    for (size_t i = gt; i < 2 * 1048576 / 4; i += gs) { const f32x4 w = *(const f32x4*)(p.fnet_w_in + i * 4); u32x2 o; o[0] = cvt_pk_bf16(w[0], w[1]); o[1] = cvt_pk_bf16(w[2], w[3]); *(u32x2*)((bf16_t*)(ws + WS_WINB) + i * 4) = o; }
    LAS float* tc = lf; LAS float* ts = lf + 2048;
    __syncthreads();
    for (int i = tid; i < 2048; i += NT) { float s_, c_; sincospif((float)i * (1.f / 1024.f), &s_, &c_); tc[i] = c_; ts[i] = s_; }
    __syncthreads();
    for (size_t i = gt; i < 2 * 65536; i += gs) { const int cs = (int)(i >> 16), a = (int)(i >> 8) & 255, b = (int)i & 255; const int r = ((a * b) & 255) * 8;
        ((bf16_t*)(ws + WS_CW))[i] = f2bf(cs ? ts[r] : tc[r]); }
    for (size_t i = gt; i < 256 * 512; i += gs) { const int lp = (int)(i >> 9), k = (int)i & 511, cs = k >> 8, l = k & 255; const int r = ((lp * l) & 255) * 8;
        ((bf16_t*)(ws + WS_DL256))[(size_t)lp * 4096 + k] = f2bf(cs ? -ts[r] : tc[r]); }
    for (size_t i = gt; i < (size_t)2048 * 4096 / 2; i += gs) { const int lp = (int)(i >> 11), k = ((int)i & 2047) * 2, cs = k >> 11, l = k & 2047; const int r0 = (lp * l) & 2047, r1 = (lp * (l + 1)) & 2047;
        ((unsigned*)(ws + WS_DL2048))[i] = cs ? cvt_pk_bf16(-ts[r0], -ts[r1]) : cvt_pk_bf16(tc[r0], tc[r1]); }
}

template <bool FINAL>
__device__ void norm_phase(const int g_wid, const Params& p, const float* src_ctx, const float* src_lat, const float* gate  , int np_ctx, int np_lat,
                           const float* g, const float* shp, const float* scp) {
    const int tid_l = LAUNDER_TID(), blk_l = LAUNDER_BLK(); unsigned char* const ws_l = LAUNDER_PTR(p.ws); (void)tid_l; (void)blk_l; (void)ws_l;
    const int lane = tid_l & 63, gw = (blk_l * NT + tid_l) >> 6, nw = (gridDim.x * NT) >> 6;
    float* X = (float*)(ws_l + WS_X); bf16_t* H = (bf16_t*)(ws_l + WS_H); const bf16_t* part = (const bf16_t*)(ws_l + WS_S + S_PART);
    for (int t0 = gw; t0 < NTOK / 2; t0 += nw) {
        f32x4 x[2][4]; u32x2 w[2][4][4]; f32x4 gtv[2][4]; int vecs[2];
#pragma unroll
        for (int q = 0; q < 2; ++q) {
            const int tok = t0 + q * (NTOK / 2);
            vecs[q] = tok < NCTX ? 0 : 1 + ((tok - NCTX) >> 11);
            const float* src = src_ctx ? (tok < NCTX ? src_ctx + (size_t)tok * D : src_lat + (size_t)(tok - NCTX) * D) : X + (size_t)tok * D;
            const int np = tok < NCTX ? np_ctx : np_lat;
#pragma unroll
            for (int u = 0; u < 4; ++u) { const int col = u * 256 + lane * 4; x[q][u] = *(const f32x4*)(src + col);
#pragma unroll
                for (int s = 0; s < 4; ++s) { w[q][u][s] = (u32x2){0u, 0u}; if (s < np) w[q][u][s] = *(const u32x2*)(part + (size_t)s * PART_STRIDE + (size_t)tok * D + col); }
                gtv[q][u] = (f32x4){0.f, 0.f, 0.f, 0.f}; if (np > 0) gtv[q][u] = *(const f32x4*)(gate + vecs[q] * 6144 + col); }
        }
#pragma unroll
        for (int q = 0; q < 2; ++q) {
            const int tok = t0 + q * (NTOK / 2), vec = vecs[q];
            float ss = 0.f;
#pragma unroll
            for (int u = 0; u < 4; ++u) { f32x4 a = {0.f, 0.f, 0.f, 0.f};
#pragma unroll
                for (int s = 0; s < 4; ++s) { a[0] += bf_lo(w[q][u][s][0]); a[1] += bf_hi(w[q][u][s][0]); a[2] += bf_lo(w[q][u][s][1]); a[3] += bf_hi(w[q][u][s][1]); }
                x[q][u] += gtv[q][u] * a;
                ss += x[q][u][0] * x[q][u][0] + x[q][u][1] * x[q][u][1] + x[q][u][2] * x[q][u][2] + x[q][u][3] * x[q][u][3]; }
#pragma unroll
            for (int o = 32; o > 0; o >>= 1) ss += __shfl_xor(ss, o);
            const float rstd = rsqrtf(ss * (1.f / 1024.f) + 1e-6f);
#pragma unroll
            for (int u = 0; u < 4; ++u) { const int col = u * 256 + lane * 4; const f32x4 gg = *(const f32x4*)(g + col);
                if (FINAL) { *(f32x4*)(p.out + (size_t)tok * D + col) = x[q][u] * rstd * gg; }
                else { if (np_ctx + np_lat > 0) *(f32x4*)(X + (size_t)tok * D + col) = x[q][u];
                    const f32x4 sh = *(const f32x4*)(shp + vec * 6144 + col), sc = *(const f32x4*)(scp + vec * 6144 + col);
                    const f32x4 h = x[q][u] * rstd * gg * (sc + 1.f) + sh; u32x2 o; o[0] = cvt_pk_bf16(h[0], h[1]); o[1] = cvt_pk_bf16(h[2], h[3]); *(u32x2*)(H + (size_t)tok * D + col) = o; } }
        }
    }
}

__device__ void gate_phase(const int g_wid, const Params& p, LAS unsigned char* ldsb, int j) {
    const int tid_l = LAUNDER_TID(), blk_l = LAUNDER_BLK(); unsigned char* const ws_l = LAUNDER_PTR(p.ws); (void)tid_l; (void)blk_l; (void)ws_l;
    LAS float* lg = (LAS float*)ldsb;
    LAS unsigned char* lt = ldsb + 8192;
    const int tid = tid_l; unsigned char* S = ws_l + WS_S;
    const bf16_t* Q = (const bf16_t*)(S + S_Q); const bf16_t* K = (const bf16_t*)(S + S_K); const bf16_t* V = (const bf16_t*)(S + S_V); const float* GLR = (const float*)(S + S_GLR);
    for (int unit = blk_l; unit < 256; unit += gridDim.x) {
        const int chunk = unit >> 1, half = unit & 1, tok0 = chunk * 64;
        for (int i = tid; i < 2048; i += NT) lg[i] = GLR[(size_t)tok0 * 32 + i];
        u32x4 vld[8];
#pragma unroll
        for (int tl = 0; tl < 8; ++tl) vld[tl] = *(const u32x4*)(V + (size_t)(tok0 + (tid >> 3)) * 1024 + half * 512 + tl * 64 + (tid & 7) * 8);
        __syncthreads();
        const int dir = __builtin_amdgcn_readfirstlane(tid >> 8), ch = half * 256 + (tid & 255);
        f32x4 w4[4];
#pragma unroll
        for (int r = 0; r < 16; ++r) w4[r >> 2][r & 3] = p.gla_w_g2[(((size_t)j * 2 + dir) * 16 + r) * 512 + ch];
        const float bg = p.gla_b_g[(j * 2 + dir) * 512 + ch];
        bf16_t* Qo = (bf16_t*)(S + (dir ? S_QB : S_QF)); bf16_t* Ko = (bf16_t*)(S + (dir ? S_KB : S_KF)); bf16_t* KTo = (bf16_t*)(S + (dir ? S_KBT : S_KFT));
        float bc = 0.f;
        unsigned short qc[8], kc[8], qn[8], kn[8];
#pragma unroll
        for (int e = 0; e < 8; ++e) { const int tt = dir ? (63 - e) : e; const size_t gi = (size_t)(tok0 + tt) * 512 + ch; qc[e] = Q[gi]; kc[e] = K[gi]; }
#pragma unroll 2
        for (int g8 = 0; g8 < 8; ++g8) {
            if (g8 < 7) {
#pragma unroll
                for (int e = 0; e < 8; ++e) { const int tt = dir ? (63 - ((g8 + 1) * 8 + e)) : ((g8 + 1) * 8 + e); const size_t gi = (size_t)(tok0 + tt) * 512 + ch; qn[e] = Q[gi]; kn[e] = K[gi]; }
            }
            float kt[8];
#pragma unroll
            for (int e = 0; e < 8; ++e) {
                const int tt = dir ? (63 - (g8 * 8 + e)) : (g8 * 8 + e);
                f32x4 lv = *(const LAS f32x4*)(lg + tt * 32 + dir * 16) * w4[0];
#pragma unroll
                for (int r4 = 1; r4 < 4; ++r4) lv += *(const LAS f32x4*)(lg + tt * 32 + dir * 16 + r4 * 4) * w4[r4];
                const float lo = bg + ((lv[0] + lv[1]) + (lv[2] + lv[3]));
                const float ls = fminf(lo, 0.f) - __logf(1.f + __expf(-fabsf(lo)));
                bc += ls * 0.0625f;
                const size_t gi = (size_t)(tok0 + tt) * 512 + ch;
                const float eb = __expf(bc);
                const float qv = bf2f(qc[e]) * eb, kv = bf2f(kc[e]) * __builtin_amdgcn_rcpf(eb);
                Qo[gi] = f2bf(qv); Ko[gi] = f2bf(kv); kt[e] = kv;
            }
            const int t8 = dir ? (7 - g8) : g8;
            u32x4 o;
            if (dir) { o[0] = cvt_pk_bf16(kt[7], kt[6]); o[1] = cvt_pk_bf16(kt[5], kt[4]); o[2] = cvt_pk_bf16(kt[3], kt[2]); o[3] = cvt_pk_bf16(kt[1], kt[0]); }
            else { o[0] = cvt_pk_bf16(kt[0], kt[1]); o[1] = cvt_pk_bf16(kt[2], kt[3]); o[2] = cvt_pk_bf16(kt[4], kt[5]); o[3] = cvt_pk_bf16(kt[6], kt[7]); }
            *(u32x4*)(KTo + ((size_t)chunk * 512 + ch) * 64 + t8 * 8) = o;
#pragma unroll
            for (int e = 0; e < 8; ++e) { qc[e] = qn[e]; kc[e] = kn[e]; }
        }
        ((float*)(S + S_EE))[((size_t)dir * 128 + chunk) * 512 + ch] = __expf(bc);
        { bf16_t* VT = (bf16_t*)(S + S_VT);
#pragma unroll
          for (int tl = 0; tl < 8; ++tl) {
              __syncthreads();
              { LAS unsigned* d = (LAS unsigned*)(lt + (tid >> 3) * 132 + (tid & 7) * 16); d[0] = vld[tl][0]; d[1] = vld[tl][1]; d[2] = vld[tl][2]; d[3] = vld[tl][3]; }
              __syncthreads();
              const int dv = tid >> 3, t8 = tid & 7; unsigned short vv[8];
#pragma unroll
              for (int e = 0; e < 8; ++e) vv[e] = *(const LAS unsigned short*)(lt + (t8 * 8 + e) * 132 + dv * 2);
              u32x4 o; o[0] = vv[0] | ((unsigned)vv[1] << 16); o[1] = vv[2] | ((unsigned)vv[3] << 16); o[2] = vv[4] | ((unsigned)vv[5] << 16); o[3] = vv[6] | ((unsigned)vv[7] << 16);
              *(u32x4*)(VT + ((size_t)chunk * 1024 + half * 512 + tl * 64 + dv) * 64 + t8 * 8) = o; } }
        __syncthreads();
    }
}

template <int NDT>
__device__ __forceinline__ void scan_unit(const Params& p, LAS unsigned char* lds, unsigned char* S, const int j, const bool lat, const int b, const int h, const int dir, const int slice,
                                          const int tid, const int w, const int r, const int q) {
    constexpr int LQ = 0, LK = 17408, LKT = 34816, LVT = 53248, OPB = 62464, LST = 2 * OPB, LAT = LST + 17408, LE = LAT + 9216;
    static_assert(LE + 1024 <= LDS_TOP, "scan LDS image");
    constexpr int DVS = 16 * NDT, TPW = NDT / 2;
    const int nc = lat ? 32 : 4, tokbase = lat ? NCTX + b * 2048 : b * 256, chunk0 = tokbase >> 6;
    const bf16_t* Qs = (const bf16_t*)(S + (dir ? S_QB : S_QF)); const bf16_t* Ks = (const bf16_t*)(S + (dir ? S_KB : S_KF));
    const bf16_t* KTs = (const bf16_t*)(S + (dir ? S_KBT : S_KFT)); const bf16_t* VTs = (const bf16_t*)(S + S_VT);
    const float* Es = (const float*)(S + S_EE) + (size_t)dir * 128 * 512;
    bf16_t* O = (bf16_t*)(S + (dir ? S_OB : S_OF));
    f32x4 acc[NDT];
#pragma unroll
    for (int nd = 0; nd < NDT; ++nd) {
#pragma unroll
        for (int jj = 0; jj < 4; ++jj) { const int kk = w * 16 + q * 4 + jj, dv = nd * 16 + r;
            acc[nd][jj] = lat ? p.state_gla[((((size_t)(b * 2 + j) * 2 + dir) * 4 + h) * 128 + kk) * 256 + slice * DVS + dv] : 0.f; }
        u32x2 o; o[0] = cvt_pk_bf16(acc[nd][0], acc[nd][1]); o[1] = cvt_pk_bf16(acc[nd][2], acc[nd][3]);
        *(LAS u32x2*)(lds + LST + (nd * 16 + r) * 272 + (w * 16 + q * 4) * 2) = o;
    }
    u32x4 pq[2], pk[2], pkt[2], pvt = {0u, 0u, 0u, 0u}; float pe = 0.f;
#define SCAN_LOAD(s_) do { const int cgl_ = chunk0 + (dir ? nc - 1 - (s_) : (s_)); const size_t t0_ = (size_t)cgl_ * 64; \
    _Pragma("unroll") for (int u = 0; u < 2; ++u) { const int i = (tid >> 4) + 32 * u, pc = tid & 15; \
        pq[u] = *(const u32x4*)(Qs + (t0_ + i) * 512 + h * 128 + pc * 8); pk[u] = *(const u32x4*)(Ks + (t0_ + i) * 512 + h * 128 + pc * 8); \
        pkt[u] = *(const u32x4*)(KTs + ((size_t)cgl_ * 512 + h * 128) * 64 + (size_t)(tid + 512 * u) * 8); } \
    if (tid < DVS * 8) pvt = *(const u32x4*)(VTs + ((size_t)cgl_ * 1024 + h * 256 + slice * DVS) * 64 + (size_t)tid * 8); \
    if (tid < 128) pe = Es[(size_t)cgl_ * 512 + h * 128 + tid]; } while (0)
#define SCAN_WRITE(ob_) do { LAS unsigned char* const lb_ = lds + (ob_) * OPB; \
    _Pragma("unroll") for (int u = 0; u < 2; ++u) { const int i = (tid >> 4) + 32 * u, pc = tid & 15; \
        *(LAS u32x4*)(lb_ + LQ + i * 272 + pc * 16) = pq[u]; *(LAS u32x4*)(lb_ + LK + i * 272 + pc * 16) = pk[u]; \
        const int id2 = tid + 512 * u; *(LAS u32x4*)(lb_ + LKT + (id2 >> 3) * 144 + (id2 & 7) * 16) = pkt[u]; } \
    if (tid < DVS * 8) *(LAS u32x4*)(lb_ + LVT + (tid >> 3) * 144 + (tid & 7) * 16) = pvt; \
    if (tid < 128) *(LAS float*)(lds + LE + (ob_) * 512 + tid * 4) = pe; } while (0)
    SCAN_LOAD(0);
    SCAN_WRITE(0);
    __syncthreads();
    for (int s = 0; s < nc; ++s) {
        const int cur = s & 1; LAS unsigned char* const lb = lds + cur * OPB;
        const int cgl = chunk0 + (dir ? nc - 1 - s : s); const size_t tok0 = (size_t)cgl * 64;
        if (s + 1 < nc) SCAN_LOAD(s + 1);
        const int mi = w >> 1, n0 = 2 * (w & 1), d0 = TPW * (w & 1);
        const f32x4 e4 = *(const LAS f32x4*)(lds + LE + cur * 512 + (w * 16 + q * 4) * 4);
        bf16x8 qa[4];
        {
            bf16x8 kb[2][4], ka[2], vb[NDT][2];
#pragma unroll
            for (int ks = 0; ks < 4; ++ks) { qa[ks] = *(const LAS bf16x8*)(lb + LQ + (mi * 16 + r) * 272 + (ks * 32 + q * 8) * 2);
#pragma unroll
                for (int t = 0; t < 2; ++t) kb[t][ks] = *(const LAS bf16x8*)(lb + LK + ((n0 + t) * 16 + r) * 272 + (ks * 32 + q * 8) * 2); }
#pragma unroll
            for (int ks = 0; ks < 2; ++ks) { ka[ks] = *(const LAS bf16x8*)(lb + LKT + (w * 16 + r) * 144 + (ks * 32 + q * 8) * 2);
#pragma unroll
                for (int nd = 0; nd < NDT; ++nd) vb[nd][ks] = *(const LAS bf16x8*)(lb + LVT + (nd * 16 + r) * 144 + (ks * 32 + q * 8) * 2); }
            f32x4 at[2] = {{0.f, 0.f, 0.f, 0.f}, {0.f, 0.f, 0.f, 0.f}};
#pragma unroll
            for (int ks = 0; ks < 4; ++ks)
#pragma unroll
                for (int t = 0; t < 2; ++t) at[t] = __builtin_amdgcn_mfma_f32_16x16x32_bf16(kb[t][ks], qa[ks], at[t], 0, 0, 0);
#pragma unroll
            for (int ks = 0; ks < 2; ++ks)
#pragma unroll
                for (int nd = 0; nd < NDT; ++nd) acc[nd] = __builtin_amdgcn_mfma_f32_16x16x32_bf16(ka[ks], vb[nd][ks], acc[nd], 0, 0, 0);
#pragma unroll
            for (int t = 0; t < 2; ++t) { const int i = mi * 16 + r, j0 = (n0 + t) * 16 + q * 4; float v[4];
#pragma unroll
                for (int jj = 0; jj < 4; ++jj) { const bool keep = dir ? (j0 + jj >= i) : (j0 + jj <= i); v[jj] = keep ? at[t][jj] : 0.f; }
                u32x2 o; o[0] = cvt_pk_bf16(v[0], v[1]); o[1] = cvt_pk_bf16(v[2], v[3]);
                *(LAS u32x2*)(lds + LAT + i * 144 + j0 * 2) = o; }
        }
        __syncthreads();
        {
            bf16x8 aa[2], vb2[TPW][2], sb[TPW][4];
#pragma unroll
            for (int ks = 0; ks < 2; ++ks) { aa[ks] = *(const LAS bf16x8*)(lds + LAT + (mi * 16 + r) * 144 + (ks * 32 + q * 8) * 2);
#pragma unroll
                for (int t = 0; t < TPW; ++t) vb2[t][ks] = *(const LAS bf16x8*)(lb + LVT + ((d0 + t) * 16 + r) * 144 + (ks * 32 + q * 8) * 2); }
#pragma unroll
            for (int ks = 0; ks < 4; ++ks)
#pragma unroll
                for (int t = 0; t < TPW; ++t) sb[t][ks] = *(const LAS bf16x8*)(lds + LST + ((d0 + t) * 16 + r) * 272 + (ks * 32 + q * 8) * 2);
            f32x4 oo[TPW];
#pragma unroll
            for (int t = 0; t < TPW; ++t) oo[t] = (f32x4){0.f, 0.f, 0.f, 0.f};
#pragma unroll
            for (int ks = 0; ks < 4; ++ks)
#pragma unroll
                for (int t = 0; t < TPW; ++t) oo[t] = __builtin_amdgcn_mfma_f32_16x16x32_bf16(sb[t][ks], qa[ks], oo[t], 0, 0, 0);
#pragma unroll
            for (int ks = 0; ks < 2; ++ks)
#pragma unroll
                for (int t = 0; t < TPW; ++t) oo[t] = __builtin_amdgcn_mfma_f32_16x16x32_bf16(vb2[t][ks], aa[ks], oo[t], 0, 0, 0);
#pragma unroll
            for (int t = 0; t < TPW; ++t) { u32x2 o; o[0] = cvt_pk_bf16(oo[t][0], oo[t][1]); o[1] = cvt_pk_bf16(oo[t][2], oo[t][3]);
                *(u32x2*)(O + (tok0 + mi * 16 + r) * 1024 + h * 256 + slice * DVS + (d0 + t) * 16 + q * 4) = o; }
        }
        if (s + 1 < nc) SCAN_WRITE(cur ^ 1);
        __syncthreads();
#pragma unroll
        for (int nd = 0; nd < NDT; ++nd) { acc[nd] = acc[nd] * e4;
            u32x2 o; o[0] = cvt_pk_bf16(acc[nd][0], acc[nd][1]); o[1] = cvt_pk_bf16(acc[nd][2], acc[nd][3]);
            *(LAS u32x2*)(lds + LST + (nd * 16 + r) * 272 + (w * 16 + q * 4) * 2) = o; }
    }
    if (!lat) {
        float* so = p.out + 2 * (size_t)NCTX * D;
#pragma unroll
        for (int nd = 0; nd < NDT; ++nd)
#pragma unroll
            for (int jj = 0; jj < 4; ++jj) { const int kk = w * 16 + q * 4 + jj, dv = nd * 16 + r;
                so[((((size_t)(b * 2 + j) * 2 + dir) * 4 + h) * 128 + kk) * 256 + slice * DVS + dv] = acc[nd][jj]; }
    }
    __syncthreads();
#undef SCAN_LOAD
#undef SCAN_WRITE
}
__device__ void scan_phase(const int g_wid, const Params& p, LAS unsigned char* lds, int j) {
    const int tid_l = LAUNDER_TID(), blk_l = LAUNDER_BLK(); unsigned char* const ws_l = LAUNDER_PTR(p.ws); (void)tid_l; (void)blk_l; (void)ws_l;
    const int tid = tid_l, w = __builtin_amdgcn_readfirstlane(tid >> 6), lane = tid & 63, r = lane & 15, q = lane >> 4;
    unsigned char* S = ws_l + WS_S;
    const int blk = blk_l, G = gridDim.x;
    for (int kq = 0;; ++kq) {
        const int ul = (G == 256) ? (blk < 128 ? (kq == 0 ? blk : 640) : blk + 128 * kq) : blk + kq * G;
        if (ul >= 640) break;
        if (ul < 128) { const int slice = ul & 7, dir = (ul >> 3) & 1, h = (ul >> 4) & 3, b = ul >> 6; scan_unit<2>(p, lds, S, j, true, b, h, dir, slice, tid, w, r, q); }
        else { const int idx = ul - 128, slice = idx & 3, dir = (idx >> 2) & 1, h = (idx >> 3) & 3, b = idx >> 5; scan_unit<4>(p, lds, S, j, false, b, h, dir, slice, tid, w, r, q); }
    }
}

__device__ void onorm_phase(const int g_wid, const Params& p, int j) {
    const int tid_l = LAUNDER_TID(), blk_l = LAUNDER_BLK(); unsigned char* const ws_l = LAUNDER_PTR(p.ws); (void)tid_l; (void)blk_l; (void)ws_l;
    const int lane = tid_l & 63, gw = (blk_l * NT + tid_l) >> 6, nw = (gridDim.x * NT) >> 6;
    unsigned char* S = ws_l + WS_S; const bf16_t* OF = (const bf16_t*)(S + S_OF); const bf16_t* OB = (const bf16_t*)(S + S_OB); const bf16_t* R = (const bf16_t*)(S + S_R);
    bf16_t* H = (bf16_t*)(ws_l + WS_H);
    const f32x4 ng = *(const f32x4*)(p.gla_norm_g + j * 256 + lane * 4);
    for (int it0 = gw; it0 < NTOK * 4; it0 += 4 * nw) {
        u32x2 a[4], b[4], rr[4]; size_t off[4]; bool ok[4];
#pragma unroll
        for (int k = 0; k < 4; ++k) { const int it = it0 + k * nw; ok[k] = it < NTOK * 4; off[k] = (size_t)(ok[k] ? it : 0) * 256 + lane * 4;
            a[k] = *(const u32x2*)(OF + off[k]); b[k] = *(const u32x2*)(OB + off[k]); rr[k] = *(const u32x2*)(R + off[k]); }
#pragma unroll
        for (int k = 0; k < 4; ++k) {
            f32x4 o = {bf_lo(a[k][0]) + bf_lo(b[k][0]), bf_hi(a[k][0]) + bf_hi(b[k][0]), bf_lo(a[k][1]) + bf_lo(b[k][1]), bf_hi(a[k][1]) + bf_hi(b[k][1])};
            float ss = o[0] * o[0] + o[1] * o[1] + o[2] * o[2] + o[3] * o[3];
#pragma unroll
            for (int x = 32; x > 0; x >>= 1) ss += __shfl_xor(ss, x);
            const float rstd = rsqrtf(ss * (1.f / 256.f) + 1e-6f);
            const f32x4 rv = {silu_f(bf_lo(rr[k][0])), silu_f(bf_hi(rr[k][0])), silu_f(bf_lo(rr[k][1])), silu_f(bf_hi(rr[k][1]))};
            const f32x4 y = o * rstd * ng * rv;
            u32x2 out; out[0] = cvt_pk_bf16(y[0], y[1]); out[1] = cvt_pk_bf16(y[2], y[3]); if (ok[k]) *(u32x2*)(H + off[k]) = out;
        }
    }
}

__device__ void convact_phase(const int g_wid, const Params& p, int layer) {
    const int tid_l = LAUNDER_TID(), blk_l = LAUNDER_BLK(); unsigned char* const ws_l = LAUNDER_PTR(p.ws); (void)tid_l; (void)blk_l; (void)ws_l;
    unsigned char* S = ws_l + WS_S; const bf16_t* A = (const bf16_t*)(S + S_UPA); const bf16_t* Gt = (const bf16_t*)(S + S_UPG); bf16_t* ACT = (bf16_t*)(S + S_ACT);
    const float* cw = p.ffn_conv_w + (size_t)layer * 3 * FFN; const float* cb = p.ffn_conv_b + (size_t)layer * FFN;
    const size_t gt = (size_t)blk_l * NT + tid_l, gs = (size_t)gridDim.x * NT;
    for (size_t it = gt; it < (size_t)512 * 352; it += gs) {
        const int seg = (int)(it / 352), c0 = (int)(it % 352) * 8, tok0 = seg * 16;
        const int lenm1 = tok0 < NCTX ? 255 : 63;
        f32x4 w0[2], w1[2], w2[2], bb[2];
#pragma unroll
        for (int h2 = 0; h2 < 2; ++h2) { w0[h2] = *(const f32x4*)(cw + c0 + 4 * h2); w1[h2] = *(const f32x4*)(cw + FFN + c0 + 4 * h2); w2[h2] = *(const f32x4*)(cw + 2 * FFN + c0 + 4 * h2); bb[h2] = *(const f32x4*)(cb + c0 + 4 * h2); }
        const u32x4 z = {0u, 0u, 0u, 0u};
        size_t off = (size_t)tok0 * FFN + c0;
        u32x4 prev = (tok0 & lenm1) > 0 ? *(const u32x4*)(A + off - FFN) : z, cur = *(const u32x4*)(A + off);
#pragma unroll 4
        for (int t = 0; t < 16; ++t, off += FFN) {
            const int pos = (tok0 + t) & lenm1;
            const u32x4 nxt = pos < lenm1 ? *(const u32x4*)(A + off + FFN) : z, gg = *(const u32x4*)(Gt + off);
            u32x4 o;
#pragma unroll
            for (int e = 0; e < 4; ++e) { const int h2 = e >> 1, x = (e & 1) * 2;
                const float v0 = bf_lo(prev[e]) * w0[h2][x] + bf_lo(cur[e]) * w1[h2][x] + bf_lo(nxt[e]) * w2[h2][x] + bb[h2][x];
                const float v1 = bf_hi(prev[e]) * w0[h2][x + 1] + bf_hi(cur[e]) * w1[h2][x + 1] + bf_hi(nxt[e]) * w2[h2][x + 1] + bb[h2][x + 1];
                o[e] = cvt_pk_bf16(silu_f(v0) * bf_lo(gg[e]), silu_f(v1) * bf_hi(gg[e])); }
            *(u32x4*)(ACT + off) = o;
            prev = cur; cur = nxt;
        }
    }
}

constexpr int N_PHASES = 1 + 11 + 6 + 9 + 6 + 1;
__device__ __forceinline__ void decode_phase(int ph, int& layer, int& kind) {
    if (ph == 0) { layer = 0; kind = 0; return; }
    ph -= 1;
    if (ph < 11) { layer = 0; kind = ph == 0 ? 10 : ph == 1 ? 11 : ph == 2 ? 1 : ph <= 6 ? 9 + ph : ph == 7 ? 30 : ph == 8 ? 31 : ph == 9 ? 2 : 33; return; }
    if (ph < 17) { layer = 1; ph -= 11; } else if (ph < 26) { layer = 2; ph -= 17; } else if (ph < 32) { layer = 3; ph -= 26; } else { layer = 4; kind = 40; return; }
    if ((layer & 1) == 0) kind = ph < 6 ? 10 + ph : (ph == 6 ? 30 : ph == 7 ? 31 : 33);
    else kind = ph == 0 ? 10 : (ph < 3 ? 19 + ph : (ph == 3 ? 30 : ph == 4 ? 31 : 33));
}

__global__ void __launch_bounds__(NT, 2) fwd_kernel(Params p) {
    extern __shared__ __attribute__((aligned(16))) unsigned char shm[];
    LAS unsigned char* lds = (LAS unsigned char*)shm;
    const int tid = threadIdx.x, G = gridDim.x; const int g_wid = __builtin_amdgcn_readfirstlane(tid >> 6);
    volatile LAS unsigned* st = (volatile LAS unsigned*)(lds + LDS_TOP);
    if (tid < 4) st[tid] = 0u;
    __syncthreads();
    XcdBarrier bar; bar.bar = (unsigned*)(p.ws + WS_CTL); bar.x = 0; bar.st = st;
    const bool multi = (p.ph_hi - p.ph_lo) > 1;
    if (multi) bar = xcd_barrier_post((unsigned*)(p.ws + WS_CTL), st);
    if (p.never) cg::this_grid().sync();
    int repdone = 0; (void)repdone;
    for (int ph = p.ph_lo; ph < p.ph_hi; ++ph) {
        int layer, kind; decode_phase(ph, layer, kind);
        unsigned char* const ws = LAUNDER_PTR(p.ws); unsigned char* const S = ws + WS_S; const int c = LAUNDER_BLK();
        const int j = layer >> 1;
        const float* MODV = (const float*)(ws + WS_MODV); const float* mv = MODV + (size_t)layer * 3 * 6144;
        bool is_gemm = true; GSched Sd{}; Sd.G = G; Sd.c = c; Sd.lda = 2048; Sd.ldb = 2048;
        switch (kind) {
        case 1: Sd.c = G - 1 - c; Sd.kind = 4; Sd.A = (const char*)(ws + WS_WINB); Sd.B = (const char*)(ws + WS_CW); Sd.ldb = 512; Sd.nt = 4; Sd.o0 = (bf16_t*)(ws + WS_T1); break;
        case 2: Sd.c = G - 1 - c; Sd.kind = 5; Sd.A = (const char*)(ws + WS_WOT); Sd.B = (const char*)(ws + WS_T1); Sd.nt = 16; Sd.o0 = (bf16_t*)(ws + WS_WCS); break;
        case 11: Sd.kind = 0; Sd.A = (const char*)(ws + WS_H); Sd.B = (const char*)(ws + WS_WGIN) + (size_t)j * GINP * 2048; Sd.nM = 32; Sd.nN = 13; Sd.nt = 16; Sd.o0 = (bf16_t*)S; break;
        case 15: Sd.kind = 3; Sd.A = (const char*)(ws + WS_H); Sd.B = (const char*)(ws + WS_WGO) + (size_t)j * 2 * MB; Sd.nt = 8; Sd.koff = 1024; Sd.o0 = (bf16_t*)(S + S_PART); break;
        case 20: Sd.kind = 2; Sd.A = (const char*)(ws + WS_WCS) + (size_t)j * 4 * MB; Sd.B = (const char*)(ws + WS_H); Sd.nM = 8; Sd.nN = 32; Sd.nt = 16;
            Sd.o0 = (bf16_t*)(S + S_HWTC); Sd.o1 = (bf16_t*)(S + S_HWTL); break;
        case 21: Sd.kind = 6; Sd.A = (const char*)(ws + WS_DL2048); Sd.B = (const char*)(S + S_HWTL); Sd.A2 = (const char*)(ws + WS_DL256); Sd.B2 = (const char*)(S + S_HWTC); Sd.lda = 8192; Sd.ldb = 16384;
            Sd.o0 = (bf16_t*)(S + S_PART); break;
        case 31: Sd.kind = 1; Sd.A = (const char*)(ws + WS_H); Sd.B = (const char*)(ws + WS_WUP) + (size_t)layer * 2 * FFN * 2048; Sd.nM = 32; Sd.nN = 22; Sd.nt = 16;
            Sd.o0 = (bf16_t*)(S + S_ACT); Sd.cw = p.ffn_conv_w + (size_t)layer * 3 * FFN; Sd.cb = p.ffn_conv_b + (size_t)layer * FFN; break;
        case 33: Sd.kind = 3; Sd.A = (const char*)(S + S_ACT); Sd.B = (const char*)(ws + WS_WDN) + (size_t)layer * 1024 * FFN * 2; Sd.lda = FFN * 2; Sd.ldb = FFN * 2; Sd.nt = 22; Sd.koff = 1408 * 2;
            Sd.o0 = (bf16_t*)(S + S_PART); break;
        default: is_gemm = false; break;
        }
        if (is_gemm) pg8::gemm_phase(g_wid, lds, Sd.lda, Sd.ldb, Sd);
        else switch (kind) {
        case 0: setup_phase(g_wid, p, lds); break;
        case 10:
            if (layer == 0) norm_phase<false>(g_wid, p, p.x_prompt, p.x_sample, nullptr, 0, 0, p.norm_mix_g, mv + 0, mv + 1024);
            else norm_phase<false>(g_wid, p, nullptr, nullptr, MODV + (size_t)(layer - 1) * 3 * 6144 + 5 * 1024, 2, 2, p.norm_mix_g + layer * 1024, mv + 0, mv + 1024);
            break;
        case 12: gate_phase(g_wid, p, lds, j); break;
        case 13: scan_phase(g_wid, p, lds, j); break;
        case 14: onorm_phase(g_wid, p, j); break;
        case 30: { const bool gla = (layer & 1) == 0;
            norm_phase<false>(g_wid, p, layer == 0 ? p.x_prompt : nullptr, layer == 0 ? p.x_sample : nullptr, mv + 2 * 1024, 2, gla ? 2 : 4, p.norm_ffn_g + layer * 1024, mv + 3 * 1024, mv + 4 * 1024); } break;
        case 40: norm_phase<true>(g_wid, p, nullptr, nullptr, MODV + (size_t)3 * 3 * 6144 + 5 * 1024, 2, 2, p.final_norm_g, nullptr, nullptr); break;
        default: break;
        }
        if (ph + 1 < p.ph_hi && ph != 2 && ph != 9) xcd_barrier(g_wid, bar);
#if REP_MASK
        if (!repdone && (((REP_MASK & 1) && is_gemm) || ((REP_MASK & 2) && kind == 13) || ((REP_MASK & 4) && kind == 0) || ((REP_MASK & 8) && (kind == 12 || kind == 14 || kind == 32)) || ((REP_MASK & 16) && kind == 12) || ((REP_MASK & 32) && kind == 14) || ((REP_MASK & 64) && kind == 32) || ((REP_MASK & 128) && kind == 33) || ((REP_MASK & 256) && kind == 31) || ((REP_MASK & 512) && kind == 11))) { repdone = 1; --ph; } else repdone = 0;
#endif
    }
}


#ifdef DBG_STOP
struct DbgBuf { size_t off; size_t n; int f32; int inS; };
__global__ void dbg_check(Params p, unsigned* flag) {
    const DbgBuf bufs[] = { {S_OF, 4194304, 0, 1} };
    const int nb = sizeof(bufs) / sizeof(bufs[0]);
    const size_t gt = (size_t)blockIdx.x * blockDim.x + threadIdx.x, gs = (size_t)gridDim.x * blockDim.x;
    for (int b = 0; b < nb && b < DBG_NBUF; ++b) {
        const unsigned char* base = p.ws + (bufs[b].inS ? WS_S : 0) + bufs[b].off; bool bad = false;
        if (bufs[b].f32) { const unsigned* q = (const unsigned*)base; for (size_t i = gt; i < bufs[b].n; i += gs) { const unsigned v = q[i]; if (v == 0xAAAAAAAAu) bad = true; } }
        else { const unsigned short* q = (const unsigned short*)base; unsigned cnt = 0; for (size_t i = gt; i < bufs[b].n; i += gs) { const unsigned short v = q[i]; if (v == 0xAAAAu) ++cnt; } if (cnt) atomicAdd(flag, cnt); }


    }
}
__global__ void dbg_fill(float* out, const unsigned* flag, size_t n_all, size_t n_first) {
    const unsigned f = *flag; const float c1 = 2.f * floorf(log2f(1.f + (float)f)), c2 = c1;
    for (size_t i = (size_t)blockIdx.x * blockDim.x + threadIdx.x; i < n_all; i += (size_t)gridDim.x * blockDim.x) out[i] = i < n_first / 2 ? c1 : (i < n_first ? c2 : 0.f);
}
#endif

extern "C" void kernel_launch(void* const* d_in, const int* in_sizes, int n_in, void* d_out, int out_size, void* d_ws, size_t ws_size, hipStream_t stream) {
    static int grid = 0;
    if (grid == 0) {
        if (n_in != 21 || ws_size < WS_END) { fprintf(stderr, "kernel_launch: unexpected n_in %d or ws_size %zu (< %zu)\n", n_in, ws_size, (size_t)WS_END); grid = -1; return; }
        int dev = 0, cus = 0, per_cu = 0;
        hipGetDevice(&dev); hipDeviceGetAttribute(&cus, hipDeviceAttributeMultiprocessorCount, dev);
        if (hipFuncSetAttribute((const void*)fwd_kernel, hipFuncAttributeMaxDynamicSharedMemorySize, LDS_BYTES) != hipSuccess) { fprintf(stderr, "kernel_launch: hipFuncSetAttribute failed\n"); grid = -1; return; }
        hipOccupancyMaxActiveBlocksPerMultiprocessor(&per_cu, (const void*)fwd_kernel, NT, LDS_BYTES);
        if (per_cu < 1) { fprintf(stderr, "kernel_launch: occupancy query says %d\n", per_cu); per_cu = 1; }
        (void)hipGetLastError();
        grid = cus;
    }
    if (grid < 0) return;
    Params p{};
    const float** pp = (const float**)&p;
    for (int i = 0; i < 21; ++i) pp[i] = (const float*)d_in[i];
    p.out = (float*)d_out; p.ws = (unsigned char*)d_ws; p.never = 0; p.pad = 0;
    hipMemsetAsync((char*)d_ws + WS_CTL, 0, 16384, stream);
#if ONE_LAUNCH
    p.ph_lo = 0; p.ph_hi = N_PHASES;
    void* args[] = {&p};
    hipError_t e = hipLaunchCooperativeKernel((const void*)fwd_kernel, dim3(grid), dim3(NT), args, LDS_BYTES, stream);
    if (e != hipSuccess) fprintf(stderr, "cooperative launch failed: %s (grid %d)\n", hipGetErrorString(e), grid);
#else
#ifdef DBG_STOP
    for (int ph = 0; ph < DBG_STOP; ++ph) { p.ph_lo = ph; p.ph_hi = ph + 1; hipLaunchKernelGGL(fwd_kernel, dim3(grid), dim3(NT), LDS_BYTES, stream, p); }

    unsigned* flag = (unsigned*)((char*)d_ws + WS_CTL + 15360);
    hipMemsetAsync(flag, 0, 4, stream);
    hipLaunchKernelGGL(dbg_check, dim3(1024), dim3(256), 0, stream, p, flag);
    hipLaunchKernelGGL(dbg_fill, dim3(1024), dim3(256), 0, stream, (float*)d_out, flag, (size_t)out_size, (size_t)NCTX * D);
#else
    for (int ph = 0; ph < N_PHASES; ++ph) { p.ph_lo = ph; p.ph_hi = ph + 1; hipLaunchKernelGGL(fwd_kernel, dim3(grid), dim3(NT), LDS_BYTES, stream, p); }
#endif
#endif
}
```

```cpp
#include <hip/hip_runtime.h>
#include <hip/hip_cooperative_groups.h>
#include <cstdio>
#include <cstdint>
namespace cg = cooperative_groups;

#ifndef REP_MASK
#define REP_MASK 0
#endif
#ifndef ONE_LAUNCH
#define ONE_LAUNCH 1
#endif

#define LAS __attribute__((address_space(3)))
typedef unsigned short bf16_t;
typedef short bf16x8 __attribute__((ext_vector_type(8)));
typedef float f32x4 __attribute__((ext_vector_type(4)));
typedef unsigned u32x4 __attribute__((ext_vector_type(4)));
typedef unsigned u32x2 __attribute__((ext_vector_type(2)));

#define LAUNDER_TID() ({ int _t = (g_wid << 6) | (int)__builtin_amdgcn_mbcnt_hi(~0u, __builtin_amdgcn_mbcnt_lo(~0u, 0u)); asm volatile("" : "+v"(_t)); _t; })
#define LAUNDER_BLK() ({ int _b = blockIdx.x; asm volatile("" : "+s"(_b)); _b; })
#define LAUNDER_PTR(x) ({ size_t _z = 0; asm volatile("" : "+s"(_z)); (x) + _z; })
constexpr int D = 1024, NTOK = 8192, NCTX = 4096, FFN = 2816, GIN = 3104, GINP = 3328;
constexpr int NT = 512;
constexpr size_t MB = 1024 * 1024;
constexpr size_t WS_CTL = 0, WS_MODV = 64 * 1024, WS_X = 1 * MB, WS_H = 33 * MB, WS_WGIN = 49 * MB, WS_WGO = 62 * MB, WS_WINB = 66 * MB,
                 WS_WOT = 70 * MB, WS_T1 = 74 * MB, WS_WCS = 82 * MB, WS_WUP = 90 * MB, WS_WDN = 134 * MB, WS_CW = 156 * MB, WS_DL256 = 157 * MB,
                 WS_DL2048 = 159 * MB, WS_S = 175 * MB, WS_END = 325 * MB;
constexpr size_t S_UPA = 0, S_UPG = 44 * MB, S_ACT = 88 * MB, S_PART = 0, S_Q = 0, S_K = 8 * MB, S_V = 16 * MB, S_R = 32 * MB, S_GLR = 48 * MB,
                 S_QF = 49 * MB, S_KF = 57 * MB, S_QB = 65 * MB, S_KB = 73 * MB, S_KFT = 81 * MB, S_KBT = 89 * MB, S_VT = 97 * MB, S_EE = 113 * MB,
                 S_OF = 114 * MB, S_OB = 130 * MB, S_HWTC = 80 * MB, S_HWTL = 96 * MB;
constexpr size_t PART_STRIDE = (size_t)NTOK * D;
constexpr int LDS_STAGE = 131072, LDS_TOP = 152576  , LDS_XB = LDS_TOP + 256  , LDS_BYTES = LDS_XB + 4096;

struct Params {
    const float *x_prompt, *x_sample, *state_gla, *c, *c_ctx, *norm_mix_g, *norm_ffn_g, *w_mod, *b_mod, *gla_w_in, *gla_w_g2, *gla_b_g, *gla_norm_g,
        *gla_w_o, *fnet_w_in, *fnet_w_o, *ffn_w_up, *ffn_conv_w, *ffn_conv_b, *ffn_w_down, *final_norm_g;
    float* out; unsigned char* ws; int ph_lo, ph_hi, never, pad;
};

typedef __bf16 bf16v2_t __attribute__((ext_vector_type(2)));
typedef float f32v2_t __attribute__((ext_vector_type(2)));
__device__ __forceinline__ unsigned cvt_pk_bf16(float lo, float hi) { const f32v2_t v = {lo, hi}; const bf16v2_t b = __builtin_convertvector(v, bf16v2_t); return __builtin_bit_cast(unsigned, b); }
__device__ __forceinline__ bf16_t f2bf(float f) { return (bf16_t)(cvt_pk_bf16(f, 0.f) & 0xffffu); }
__device__ __forceinline__ float bf_lo(unsigned u) { return __uint_as_float(u << 16); }
__device__ __forceinline__ float bf_hi(unsigned u) { return __uint_as_float(u & 0xffff0000u); }
__device__ __forceinline__ float bf2f(bf16_t b) { return __uint_as_float(((unsigned)b) << 16); }
__device__ __forceinline__ float silu_f(float x) { return x / (1.f + __expf(-x)); }

#define XB_TMO      128
#define XB_XCNT(j)  (256  + 64 * (j))
#define XB_XSUB(j)  (1280 + 64 * (j))
#define XB_XGEN(j)  (2304 + 64 * (j))
#define XB_TOP      3328
#define XB_TOPGEN   3392
#define XCD_BAR_WORDS 3456
#define XB_SPIN_CAP (1u << 20)
__device__ __forceinline__ unsigned xb_ld(unsigned* p)              { return __hip_atomic_load(p, __ATOMIC_RELAXED, __HIP_MEMORY_SCOPE_AGENT); }
__device__ __forceinline__ unsigned xb_add(unsigned* p, unsigned v) { return __hip_atomic_fetch_add(p, v, __ATOMIC_RELAXED, __HIP_MEMORY_SCOPE_AGENT); }
__device__ __forceinline__ unsigned xb_xcc_id() { return (unsigned)__builtin_amdgcn_s_getreg((3 << 11) | 20) & 0xFu; }
#define XB_SPIN(cond, bar) do { unsigned _sp = 0; while (cond) { __builtin_amdgcn_s_sleep(1); \
    if ((++_sp & 255u) == 0u) { if (xb_ld(&(bar)[XB_TMO])) break; if (_sp > XB_SPIN_CAP) { atomicAdd(&(bar)[XB_TMO], 1u); break; } } } } while (0)
struct XcdBarrier { unsigned* bar; unsigned x; volatile LAS unsigned* st; };
__device__ __forceinline__ XcdBarrier xcd_barrier_post(unsigned* bar, volatile LAS unsigned* st) {
    XcdBarrier b; b.bar = bar; b.x = xb_xcc_id(); b.st = st;
    if (threadIdx.x == 0) (void)xb_add(&bar[XB_XCNT(b.x)], 1u);
    return b;
}
__device__ __forceinline__ void xcd_barrier_complete(unsigned* bar, unsigned x, unsigned& nloc, unsigned& nx) {
    const unsigned G = gridDim.x * gridDim.y * gridDim.z;
    unsigned sum, cnt, mine, sp = 0u;
    for (;;) {
        sum = 0u; cnt = 0u; mine = 0u;
#pragma unroll
        for (unsigned j = 0; j < 16; ++j) { const unsigned c = xb_ld(&bar[XB_XCNT(j)]); sum += c; cnt += (c > 0u) ? 1u : 0u; mine = (j == x) ? c : mine; }
        if (sum == G) break;
        __builtin_amdgcn_s_sleep(1);
        if ((++sp & 255u) == 0u) { if (xb_ld(&bar[XB_TMO])) break; if (sp > XB_SPIN_CAP) { atomicAdd(&bar[XB_TMO], 1u); break; } }
    }
    nloc = mine > 0u ? mine : 1u; nx = cnt > 0u ? cnt : 1u;
}
__device__ __forceinline__ void xcd_barrier(const int g_wid, const XcdBarrier& b) {
    asm volatile("s_waitcnt vmcnt(0)" ::: "memory");
    __syncthreads();
    if (LAUNDER_TID() == 0) {
        unsigned* bar = b.bar;
        __builtin_amdgcn_s_waitcnt(0);
        unsigned nloc = b.st[0], nx = b.st[1];
        if (nloc == 0u) { xcd_barrier_complete(bar, b.x, nloc, nx); b.st[0] = nloc; b.st[1] = nx; }
        const unsigned old = xb_add(&bar[XB_XSUB(b.x)], 1u);
        const unsigned gen = old / nloc;
        if (old + 1u == (gen + 1u) * nloc) {
            __builtin_amdgcn_fence(__ATOMIC_RELEASE, "agent");
            asm volatile("s_waitcnt vmcnt(0)" ::: "memory");
            const unsigned og = xb_add(&bar[XB_TOP], 1u);
            const unsigned tg = og / nx;
            if (og + 1u == (tg + 1u) * nx) xb_add(&bar[XB_TOPGEN], 1u);
            else XB_SPIN(xb_ld(&bar[XB_TOPGEN]) == tg, bar);
            __builtin_amdgcn_fence(__ATOMIC_ACQUIRE, "agent");
            xb_add(&bar[XB_XGEN(b.x)], 1u);
            asm volatile("s_waitcnt vmcnt(0)" ::: "memory");
        } else {
            XB_SPIN(xb_ld(&bar[XB_XGEN(b.x)]) == gen, bar);
            __builtin_amdgcn_fence(__ATOMIC_ACQUIRE, "agent");
            asm volatile("s_waitcnt vmcnt(0)" ::: "memory");
        }
    }
    __syncthreads();
}

namespace pg8 {
constexpr int BM = 256, BK = 64, HALF = 128, HTB = HALF * BK * 2, NXCD = 8, WGM = 8;
__device__ __forceinline__ int lds_byte(int r, int c) { const int st = (r >> 4) * 2 + (c >> 5), rr = r & 15, cc = c & 31, ob = rr * 64 + cc * 2; return st * 1024 + (ob ^ (((ob >> 9) & 1) << 5)); }
__device__ __forceinline__ void stage_rc(int b, int& R, int& C) { const int st = b / 1024, sb = b % 1024, swz = sb ^ (((sb >> 9) & 1) << 5); R = (st >> 1) * 16 + swz / 64; C = (st & 1) * 32 + (swz % 64) / 2; }
__device__ __forceinline__ int perm32(int rho) { const int n = rho >> 4, i = rho & 15; return 8 * (i >> 2) + 4 * n + (i & 3); }
struct Unit { const char* A; const char* B; bf16_t* dst; int nt; int ldo; float scale; int f32; int cch; };
__device__ __forceinline__ bool tile_order(long L, int nM, int nN, int& pm, int& pn) {
    const int nwg = nM * nN; if (L >= nwg) return false;
    int wgid = (int)L; { const int q = nwg / NXCD, r = nwg % NXCD, xcd = wgid % NXCD, off = wgid / NXCD; wgid = (xcd < r ? xcd * (q + 1) : r * (q + 1) + (xcd - r) * q) + off; }
    const int nig = WGM * nN, gid = wgid / nig, fm = gid * WGM, gsz = (nM - fm) < WGM ? (nM - fm) : WGM;
    pm = fm + ((wgid % nig) % gsz); pn = (wgid % nig) / gsz; return true;
}
__device__ __forceinline__ float dpp_ror1(float v) { return __builtin_bit_cast(float, __builtin_amdgcn_mov_dpp(__builtin_bit_cast(int, v), 0x121, 0xf, 0xf, true)); }
__device__ __forceinline__ float dpp_rol1(float v) { return __builtin_bit_cast(float, __builtin_amdgcn_mov_dpp(__builtin_bit_cast(int, v), 0x12F, 0xf, 0xf, true)); }
__device__ __forceinline__ void run_epi_glu(const f32x4 (&acc)[2][2][4][2], const Unit& u, int wr, int wc, int fr, const int fq, const float* cw, const float* cb, LAS float* xb) {
    int cl = wc * 32 + 8 * fq;
    asm volatile("" : "+v"(cl), "+v"(fr));
    const bool ctx = u.f32 == 3;
    if (ctx) {
#pragma unroll
        for (int ai = 0; ai < 2; ++ai) { const int ci = 2 * ai + wr;
            if (fr == 0) { *(LAS f32x4*)(xb + (ci * 2 + 0) * 128 + cl) = acc[ai][0][0][0]; *(LAS f32x4*)(xb + (ci * 2 + 0) * 128 + cl + 4) = acc[ai][0][0][1]; }
            if (fr == 15) { *(LAS f32x4*)(xb + (ci * 2 + 1) * 128 + cl) = acc[ai][0][3][0]; *(LAS f32x4*)(xb + (ci * 2 + 1) * 128 + cl + 4) = acc[ai][0][3][1]; } }
        asm volatile("s_waitcnt lgkmcnt(0)" ::: "memory");
        __builtin_amdgcn_s_barrier();
        asm volatile("" ::: "memory");
    }
    bf16_t* base = u.dst + (size_t)(wr * 64 + fr) * FFN + cl;
#pragma unroll
    for (int h = 0; h < 2; ++h) {
        const int c = u.cch + cl + 4 * h;
        const f32x4 w0 = *(const f32x4*)(cw + c), w1 = *(const f32x4*)(cw + FFN + c), w2 = *(const f32x4*)(cw + 2 * FFN + c), bb = *(const f32x4*)(cb + c);
#pragma unroll
        for (int ai = 0; ai < 2; ++ai) {
            const int ci = 2 * ai + wr;
            f32x4 top = {0.f, 0.f, 0.f, 0.f}, bot = {0.f, 0.f, 0.f, 0.f};
            if (ctx) {
                if (ci > 0) top = *(const LAS f32x4*)(xb + ((ci - 1) * 2 + 1) * 128 + cl + 4 * h);
                if (ci < 3) bot = *(const LAS f32x4*)(xb + ((ci + 1) * 2 + 0) * 128 + cl + 4 * h);
            }
#pragma unroll
            for (int m = 0; m < 4; ++m) {
                float y[4];
#pragma unroll
                for (int x = 0; x < 4; ++x) {
                    const float cur = acc[ai][0][m][h][x];
                    const float upv = (m > 0) ? dpp_ror1(acc[ai][0][m > 0 ? m - 1 : 0][h][x]) : top[x];
                    const float dnv = (m < 3) ? dpp_rol1(acc[ai][0][m < 3 ? m + 1 : 3][h][x]) : bot[x];
                    const float prev = __builtin_bit_cast(float, __builtin_amdgcn_update_dpp(__builtin_bit_cast(int, upv), __builtin_bit_cast(int, cur), 0x111, 0xf, 0xf, false));
                    const float next = __builtin_bit_cast(float, __builtin_amdgcn_update_dpp(__builtin_bit_cast(int, dnv), __builtin_bit_cast(int, cur), 0x101, 0xf, 0xf, false));
                    const float v = prev * w0[x] + cur * w1[x] + next * w2[x] + bb[x];
                    y[x] = v * __builtin_amdgcn_rcpf(1.f + __expf(-v)) * acc[ai][1][m][h][x];
                }
                u32x2 o; o[0] = cvt_pk_bf16(y[0], y[1]); o[1] = cvt_pk_bf16(y[2], y[3]);
                *(u32x2*)(base + (size_t)(ai * HALF + m * 16) * FFN + 4 * h) = o;
            }
        }
    }
    if (ctx) asm volatile("s_waitcnt lgkmcnt(0)" ::: "memory");
}
__device__ __forceinline__ void run_epi(const f32x4 (&acc)[2][2][4][2], const Unit& u, int wr, int wc, int fr, int fq) {
    const float s = u.scale;
    if (u.f32) {
        if (wc == 0) {
#pragma unroll
            for (int ai = 0; ai < 2; ++ai)
#pragma unroll
                for (int m = 0; m < 4; ++m) { float* d = (float*)u.dst + (size_t)(ai * HALF + wr * 64 + m * 16 + fr) * 32 + 8 * fq; *(f32x4*)d = acc[ai][0][m][0]; *(f32x4*)(d + 4) = acc[ai][0][m][1]; }
        }
        return;
    }
    const __amdgpu_buffer_rsrc_t rs = __builtin_amdgcn_make_buffer_rsrc((void*)u.dst, (short)0, 0x7FFFFFF0, 0x00020000);
    const unsigned ldb2 = (unsigned)u.ldo * 2u;
    const unsigned boff = (unsigned)(wr * 64 + fr) * ldb2 + (unsigned)(wc * 32 + 8 * fq) * 2u;
#pragma unroll
    for (int ai = 0; ai < 2; ++ai)
#pragma unroll
        for (int m = 0; m < 4; ++m)
#pragma unroll
            for (int bj = 0; bj < 2; ++bj) { const f32x4 v0 = acc[ai][bj][m][0], v1 = acc[ai][bj][m][1];
                u32x4 o; o[0] = cvt_pk_bf16(v0[0] * s, v0[1] * s); o[1] = cvt_pk_bf16(v0[2] * s, v0[3] * s); o[2] = cvt_pk_bf16(v1[0] * s, v1[1] * s); o[3] = cvt_pk_bf16(v1[2] * s, v1[3] * s);
                __builtin_amdgcn_raw_buffer_store_b128(o, rs, boff + (unsigned)(ai * HALF + m * 16) * ldb2 + (unsigned)(bj * HALF * 2), 0,   16); }
}
template <class Sched>
__device__ __forceinline__ void gemm_phase(const int g_wid, LAS unsigned char* lds, const int lda, const int ldb  , const Sched& S) {
    const int tid = LAUNDER_TID(), wid = __builtin_amdgcn_readfirstlane(tid >> 6), lane = tid & 63, wr = wid >> 2, wc = wid & 3, fr = lane & 15, fq = lane >> 4;
    unsigned voffA[2], voffB[2];
#pragma unroll
    for (int i = 0; i < 2; ++i) { int R, C; stage_rc(tid * 16 + i * 8192, R, C); const int Rb = (R & ~31) + perm32(R & 31);
        voffA[i] = (unsigned)(R * lda + C * 2); voffB[i] = (unsigned)(Rb * ldb + C * 2); }
    const size_t kstep = (size_t)(BK * 2);
    const size_t hstepA = (size_t)HALF * lda, hstepB = (size_t)HALF * ldb;
    const unsigned ldsw = (unsigned)wid * 1024u;
    const int aoff = lds_byte(wr * 64 + fr, fq * 8), boff = lds_byte(wc * 32 + fr, fq * 8);
#define PG8_SA(b, h) (((b) * 2 + (h)) * HTB)
#define PG8_SB(b, h) ((4 + (b) * 2 + (h)) * HTB)
#define PG8_STAGE(bufoff, gbase, voff) do { _Pragma("unroll") for (int _i = 0; _i < 2; ++_i) \
        __builtin_amdgcn_global_load_lds((const unsigned*)((const char*)(gbase) + (voff)[_i]), (LAS unsigned*)(lds + (bufoff) + ldsw + _i * 8192), 16, 0, 0); } while (0)
#define PG8_LDA(dst, b, h) do { _Pragma("unroll") for (int m = 0; m < 4; ++m) _Pragma("unroll") for (int k = 0; k < 2; ++k) dst[m][k] = *(const LAS bf16x8*)(lds + PG8_SA(b, h) + aoff + m * 2048 + k * 1024); } while (0)
#define PG8_LDB(dst, b, h) do { _Pragma("unroll") for (int n = 0; n < 2; ++n) _Pragma("unroll") for (int k = 0; k < 2; ++k) dst[n][k] = *(const LAS bf16x8*)(lds + PG8_SB(b, h) + boff + n * 2048 + k * 1024); } while (0)
#define PG8_MMA(ai, bj, At, Bt) do { __builtin_amdgcn_s_setprio(1); _Pragma("unroll") for (int m = 0; m < 4; ++m) _Pragma("unroll") for (int n = 0; n < 2; ++n) _Pragma("unroll") for (int k = 0; k < 2; ++k) \
        acc[ai][bj][m][n] = __builtin_amdgcn_mfma_f32_16x16x32_bf16(Bt[n][k], At[m][k], acc[ai][bj][m][n], 0, 0, 0); __builtin_amdgcn_s_setprio(0); } while (0)
#define PG8_WAIT_V(n) asm volatile("s_waitcnt vmcnt(" #n ")" ::: "memory")
#define PG8_WAIT_L(n) asm volatile("s_waitcnt lgkmcnt(" #n ")" ::: "memory")
#define PG8_BAR __builtin_amdgcn_s_barrier()
#define PG8_SCHED __builtin_amdgcn_sched_barrier(0)
    Unit cur, nxt; int ui = 0;
    if (!S.next(0, cur)) return;
    f32x4 acc[2][2][4][2];
#pragma unroll
    for (int a = 0; a < 2; ++a)
#pragma unroll
        for (int b = 0; b < 2; ++b)
#pragma unroll
            for (int m = 0; m < 4; ++m)
#pragma unroll
                for (int n = 0; n < 2; ++n) acc[a][b][m][n] = (f32x4){0.f, 0.f, 0.f, 0.f};
    bf16x8 At[4][2], B0[2][2], B1[2][2];
    const char* cA = cur.A; const char* cB = cur.B;
    PG8_STAGE(PG8_SB(0, 0), cB, voffB); PG8_STAGE(PG8_SA(0, 0), cA, voffA); PG8_STAGE(PG8_SB(0, 1), cB + hstepB, voffB); PG8_STAGE(PG8_SA(0, 1), cA + hstepA, voffA);
    if (wr == 1) PG8_BAR;
    PG8_WAIT_V(4); PG8_BAR;
    PG8_STAGE(PG8_SB(1, 0), cB + kstep, voffB); PG8_STAGE(PG8_SA(1, 0), cA + kstep, voffA); PG8_STAGE(PG8_SB(1, 1), cB + hstepB + kstep, voffB);
    PG8_WAIT_V(6); PG8_BAR;
    for (;;) {
        const bool has_next = S.next(ui + 1, nxt);
        const char* nA = has_next ? nxt.A : cA; const char* nB = has_next ? nxt.B : cB;
        const int nt = cur.nt;
        for (int t = 0; t < nt; t += 2) {
            const bool last = (t == nt - 2);
            const char* a1 = cA + (size_t)(t + 1) * kstep;
            const char* a2 = last ? nA : cA + (size_t)(t + 2) * kstep; const char* b2 = last ? nB : cB + (size_t)(t + 2) * kstep;
            const char* a3 = a2 + kstep; const char* b3 = b2 + kstep;
            PG8_LDB(B0, 0, 0); PG8_SCHED; PG8_LDA(At, 0, 0); PG8_STAGE(PG8_SA(1, 1), a1 + hstepA, voffA);
            PG8_WAIT_L(8); PG8_BAR; PG8_WAIT_L(0); PG8_MMA(0, 0, At, B0); PG8_BAR; PG8_SCHED;
            PG8_LDB(B1, 0, 1); PG8_STAGE(PG8_SB(0, 0), b2, voffB);
            PG8_BAR; PG8_WAIT_L(0); PG8_MMA(0, 1, At, B1); PG8_BAR;
            PG8_LDA(At, 0, 1); PG8_STAGE(PG8_SA(0, 0), a2, voffA);
            PG8_BAR; PG8_WAIT_L(0); PG8_MMA(1, 0, At, B0); PG8_BAR; PG8_SCHED;
            PG8_STAGE(PG8_SB(0, 1), b2 + hstepB, voffB);
            PG8_WAIT_V(6); PG8_BAR; PG8_MMA(1, 1, At, B1); PG8_BAR;
            PG8_LDB(B0, 1, 0); PG8_SCHED; PG8_LDA(At, 1, 0); PG8_STAGE(PG8_SA(0, 1), a2 + hstepA, voffA);
            PG8_WAIT_L(8); PG8_BAR; PG8_WAIT_L(0); PG8_MMA(0, 0, At, B0); PG8_BAR; PG8_SCHED;
            PG8_LDB(B1, 1, 1); PG8_STAGE(PG8_SB(1, 0), b3, voffB);
            PG8_BAR; PG8_WAIT_L(0); PG8_MMA(0, 1, At, B1); PG8_BAR;
            PG8_LDA(At, 1, 1); PG8_STAGE(PG8_SA(1, 0), a3, voffA);
            PG8_BAR; PG8_WAIT_L(0); PG8_MMA(1, 0, At, B0); PG8_BAR; PG8_SCHED;
            PG8_STAGE(PG8_SB(1, 1), b3 + hstepB, voffB);
            PG8_WAIT_V(6); PG8_BAR; PG8_MMA(1, 1, At, B1); PG8_BAR;
        }
        if (wr == 0) PG8_BAR;
        if (cur.f32 >= 2) run_epi_glu(acc, cur, wr, wc, fr, fq, S.cw, S.cb, (LAS float*)(lds + LDS_XB)); else run_epi(acc, cur, wr, wc, fr, fq);
        if (!has_next) break;
        if (wr == 1) PG8_BAR;
#pragma unroll
        for (int a = 0; a < 2; ++a)
#pragma unroll
            for (int b = 0; b < 2; ++b)
#pragma unroll
                for (int m = 0; m < 4; ++m)
#pragma unroll
                    for (int n = 0; n < 2; ++n) acc[a][b][m][n] = (f32x4){0.f, 0.f, 0.f, 0.f};
        cur = nxt; cA = nA; cB = nB; ++ui;
    }
    PG8_WAIT_V(0);
    PG8_BAR;
#undef PG8_SA
#undef PG8_SB
#undef PG8_STAGE
#undef PG8_LDA
#undef PG8_LDB
#undef PG8_MMA
#undef PG8_WAIT_V
#undef PG8_WAIT_L
#undef PG8_BAR
#undef PG8_SCHED
}
}
using pg8::Unit;

struct GSched { int kind; const char* A; const char* B; const char* A2; const char* B2; bf16_t* o0; bf16_t* o1; const float* cw; const float* cb; int lda, ldb, nM, nN, nt, koff, G, c;
    __device__ __forceinline__ bool next(int i, Unit& u) const {
        u.scale = 1.f; u.f32 = 0; u.nt = nt; u.cch = 0;
        if (kind <= 2) { int pm, pn; if (!pg8::tile_order((long)i * G + c, nM, nN, pm, pn)) return false;
            u.A = A + (size_t)pm * 256 * lda; u.B = B + (size_t)pn * 256 * ldb;
            if (kind == 0) {
                if (pn < 2) { u.dst = (bf16_t*)((char*)o0 + S_Q) + (size_t)pm * 256 * 512 + pn * 256; u.ldo = 512; u.scale = 0.08838834764831845f; }
                else if (pn < 4) { u.dst = (bf16_t*)((char*)o0 + S_K) + (size_t)pm * 256 * 512 + (pn - 2) * 256; u.ldo = 512; }
                else if (pn < 8) { u.dst = (bf16_t*)((char*)o0 + S_V) + (size_t)pm * 256 * 1024 + (pn - 4) * 256; u.ldo = 1024; }
                else if (pn < 12) { u.dst = (bf16_t*)((char*)o0 + S_R) + (size_t)pm * 256 * 1024 + (pn - 8) * 256; u.ldo = 1024; }
                else { u.dst = (bf16_t*)((float*)((char*)o0 + S_GLR) + (size_t)pm * 256 * 32); u.ldo = 0; u.f32 = 1; } }
            else if (kind == 1) { u.ldo = FFN; u.dst = o0 + (size_t)pm * 256 * FFN + pn * 128; u.cch = pn * 128; u.f32 = pm < 16 ? 3 : 2; }
            else { const int cs = pm >> 2, n0 = (pm & 3) * 256; u.ldo = 8192;
                if (pn < 16) u.dst = o0 + (size_t)n0 * 8192 + pn * 512 + cs * 256;
                else { const int t0 = (pn - 16) * 256, b = t0 >> 11, l0 = t0 & 2047; u.dst = o1 + (size_t)n0 * 8192 + b * 4096 + cs * 2048 + l0; } }
            return true; }
        if (kind == 3) { int pm, p8; if (!pg8::tile_order((long)i * G + c, 32, 8, pm, p8)) return false; const int pn = p8 & 3, ks = p8 >> 2;
            u.A = A + (size_t)pm * 256 * lda + (size_t)ks * koff; u.B = B + (size_t)pn * 256 * ldb + (size_t)ks * koff;
            u.dst = o0 + (size_t)ks * PART_STRIDE + (size_t)pm * 256 * D + pn * 256; u.ldo = D; return true; }
        if (kind == 4) { const int id = i * G + c; if (id >= 64) return false; const int pm = id & 3, g = (id >> 2) & 3, cs = (id >> 4) & 1, layer = id >> 5;
            u.A = A + (size_t)layer * 2 * MB + (size_t)pm * 256 * 2048 + g * 512; u.B = B + (size_t)cs * 256 * 512;
            u.dst = o0 + (size_t)(id >> 4) * 1048576 + (size_t)pm * 256 * 1024 + g * 256; u.ldo = 1024; return true; }
        if (kind == 5) { const int id = i * G + c; if (id >= 64) return false; const int pn = id & 3, pm = (id >> 2) & 3, lc = id >> 4, layer = lc >> 1, cs = lc & 1;
            u.A = A + (size_t)layer * 2 * MB + (size_t)pm * 256 * 2048; u.B = B + (size_t)lc * 2 * MB + (size_t)pn * 256 * 2048;
            u.dst = o0 + (size_t)layer * 2097152 + (size_t)(cs * 1024 + pm * 256) * 1024 + pn * 256; u.ldo = 1024; return true; }
        {
            u.ldo = D;
            if (G != 256) {
                const int L = i * G + c; if (L >= 384) return false;
                if (L < 256) { const int ks = L & 3, pn = (L >> 2) & 3, pm = (L >> 4) & 7, b = L >> 7;
                    u.A = A + (size_t)pm * 256 * 8192 + ks * 2048; u.B = B + (size_t)pn * 256 * 16384 + (size_t)b * 8192 + ks * 2048; u.nt = 16;
                    u.dst = o0 + (size_t)ks * PART_STRIDE + (size_t)(NCTX + b * 2048 + pm * 256) * D + pn * 256; u.scale = 0.0013810679320049757f; return true; }
                const int id = L - 256, ks = id & 1, pn = (id >> 1) & 3, b = id >> 3;
                u.A = A2 + ks * 512; u.B = B2 + (size_t)pn * 256 * 16384 + (size_t)b * 1024 + ks * 512; u.nt = 4;
                u.dst = o0 + (size_t)ks * PART_STRIDE + (size_t)b * 256 * D + pn * 256; u.scale = 0.00390625f; return true; }
            if (i == 0) { const int id = c; if (id >= 256) return false; const int ks = id & 3, pn = (id >> 2) & 3, pm = (id >> 4) & 7, b = id >> 7;
                u.A = A + (size_t)pm * 256 * 8192 + ks * 2048; u.B = B + (size_t)pn * 256 * 16384 + (size_t)b * 8192 + ks * 2048; u.nt = 16;
                u.dst = o0 + (size_t)ks * PART_STRIDE + (size_t)(NCTX + b * 2048 + pm * 256) * D + pn * 256; u.scale = 0.0013810679320049757f; return true; }
            if (i == 1) { const int id = G - 1 - c; if (id >= 128) return false; const int ks = id & 1, pn = (id >> 1) & 3, b = id >> 3;
                u.A = A2 + ks * 512; u.B = B2 + (size_t)pn * 256 * 16384 + (size_t)b * 1024 + ks * 512; u.nt = 4;
                u.dst = o0 + (size_t)ks * PART_STRIDE + (size_t)b * 256 * D + pn * 256; u.scale = 0.00390625f; return true; }
            return false; }
    } };

__device__ void setup_phase(const int g_wid, const Params& p, LAS unsigned char* ldsb) {
    const int tid_l = LAUNDER_TID(), blk_l = LAUNDER_BLK(); unsigned char* const ws_l = LAUNDER_PTR(p.ws); (void)tid_l; (void)blk_l; (void)ws_l;
    LAS float* lf = (LAS float*)ldsb;
    const int tid = tid_l, blk = blk_l, G = gridDim.x;
    unsigned char* ws = ws_l;
    for (int job = blk; job < 256; job += G) {
        const int layer = job >> 6, col0 = (job & 63) * 96;
        for (int i = tid; i < 3072; i += NT) { const int v = i >> 10, k = i & 1023; const float x = (v == 0) ? p.c_ctx[k] : p.c[(v - 1) * 1024 + k]; lf[i] = silu_f(x); }
        __syncthreads();
        if (tid < 384) {
            const int cq = tid % 24, rg = tid / 24;
            f32x4 a0 = {0.f, 0.f, 0.f, 0.f}, a1 = a0, a2 = a0;
            const float* wp = p.w_mod + ((size_t)layer * 1024 + rg * 64) * 6144 + col0 + cq * 4;
#pragma unroll 32
            for (int k = 0; k < 64; ++k) { const f32x4 w = *(const f32x4*)(wp + (size_t)k * 6144); const int kk = rg * 64 + k;
                a0 += w * lf[kk]; a1 += w * lf[1024 + kk]; a2 += w * lf[2048 + kk]; }
            LAS float* red = lf + 3072;
#pragma unroll
            for (int e = 0; e < 4; ++e) { red[(rg * 3 + 0) * 96 + cq * 4 + e] = a0[e]; red[(rg * 3 + 1) * 96 + cq * 4 + e] = a1[e]; red[(rg * 3 + 2) * 96 + cq * 4 + e] = a2[e]; }
        }
        __syncthreads();
        if (tid < 288) { const int v = tid / 96, cc = tid % 96; float s = p.b_mod[layer * 6144 + col0 + cc];
            for (int rg = 0; rg < 16; ++rg) s += lf[3072 + (rg * 3 + v) * 96 + cc];
            ((float*)(ws + WS_MODV))[(layer * 3 + v) * 6144 + col0 + cc] = s; }
        __syncthreads();
    }
    {
        constexpr int T_GIN = 2 * 16 * 13, T_GO = 2 * 16 * 4, T_FO = 2 * 16 * 4, T_UP = 4 * 16 * 22, T_DN = 4 * 44 * 4, T_ALL = T_GIN + T_GO + T_FO + T_UP + T_DN;
        for (int job = blk; job < T_ALL; job += G) {
            const float* src; bf16_t* dst; int K, N, kt, ntile; int j = job; bool up = false;
            if (j < T_GIN) { const int l = j / (16 * 13); j %= 16 * 13; kt = j / 13; ntile = j % 13; K = 1024; N = GIN; src = p.gla_w_in + (size_t)l * 1024 * GIN; dst = (bf16_t*)(ws + WS_WGIN) + (size_t)l * GINP * 1024; }
            else if ((j -= T_GIN) < T_GO) { const int l = j / 64; j %= 64; kt = j / 4; ntile = j % 4; K = 1024; N = 1024; src = p.gla_w_o + (size_t)l * 1048576; dst = (bf16_t*)(ws + WS_WGO) + (size_t)l * 1048576; }
            else if ((j -= T_GO) < T_FO) { const int l = j / 64; j %= 64; kt = j / 4; ntile = j % 4; K = 1024; N = 1024; src = p.fnet_w_o + (size_t)l * 1048576; dst = (bf16_t*)(ws + WS_WOT) + (size_t)l * 1048576; }
            else if ((j -= T_FO) < T_UP) { const int l = j / (16 * 22); j %= 16 * 22; kt = j / 22; ntile = j % 22; up = true; K = 1024; N = 2 * FFN; src = p.ffn_w_up + (size_t)l * 1024 * 2 * FFN; dst = (bf16_t*)(ws + WS_WUP) + (size_t)l * 2 * FFN * 1024; }
            else { j -= T_UP; const int l = j / (44 * 4); j %= 44 * 4; kt = j / 4; ntile = j % 4; K = FFN; N = 1024; src = p.ffn_w_down + (size_t)l * FFN * 1024; dst = (bf16_t*)(ws + WS_WDN) + (size_t)l * 1024 * FFN; }
            const int k0 = kt * 64, n0 = ntile * 256;
            f32x4 wv[8];
#pragma unroll
            for (int u = 0; u < 8; ++u) { const int kr = (tid >> 6) + 8 * u, n = n0 + (tid & 63) * 4; wv[u] = (f32x4){0.f, 0.f, 0.f, 0.f}; if (n < N) wv[u] = *(const f32x4*)(src + (size_t)(k0 + kr) * N + n); }
#pragma unroll
            for (int u = 0; u < 8; ++u) { const int kr = (tid >> 6) + 8 * u;
#pragma unroll
                for (int e = 0; e < 4; ++e) lf[kr * 257 + (tid & 63) * 4 + e] = wv[u][e]; }
            __syncthreads();
            { const int n = tid >> 1, kh = tid & 1; int orow = n0 + n;
              if (up) { const int part = n0 >= FFN ? 1 : 0, ch = n0 + n - part * FFN; orow = (ch >> 7) * 256 + part * 128 + (ch & 127); }
#pragma unroll
              for (int c4 = 0; c4 < 4; ++c4) { u32x4 o;
#pragma unroll
                  for (int e = 0; e < 4; ++e) o[e] = cvt_pk_bf16(lf[(kh * 32 + c4 * 8 + 2 * e) * 257 + n], lf[(kh * 32 + c4 * 8 + 2 * e + 1) * 257 + n]);
                  *(u32x4*)(dst + (size_t)orow * K + k0 + kh * 32 + c4 * 8) = o; } }
            __syncthreads();
        }
    }
    const size_t gt = (size_t)blk * NT + tid, gs = (size_t)G * NT;
    for (size_t i = gt; i < 2 * 1048576 / 4; i += gs) { const f32x4 w = *(const f32x4*)(p.fnet_w_in + i * 4); u32x2 o; o[0] = cvt_pk_bf16(w[0], w[1]); o[1] = cvt_pk_bf16(w[2], w[3]); *(u32x2*)((bf16_t*)(ws + WS_WINB) + i * 4) = o; }
    LAS float* tc = lf; LAS float* ts = lf + 2048;
    __syncthreads();
    for (int i = tid; i < 2048; i += NT) { float s_, c_; sincospif((float)i * (1.f / 1024.f), &s_, &c_); tc[i] = c_; ts[i] = s_; }
    __syncthreads();
    for (size_t i = gt; i < 2 * 65536; i += gs) { const int cs = (int)(i >> 16), a = (int)(i >> 8) & 255, b = (int)i & 255; const int r = ((a * b) & 255) * 8;
        ((bf16_t*)(ws + WS_CW))[i] = f2bf(cs ? ts[r] : tc[r]); }
    for (size_t i = gt; i < 256 * 512; i += gs) { const int lp = (int)(i >> 9), k = (int)i & 511, cs = k >> 8, l = k & 255; const int r = ((lp * l) & 255) * 8;
        ((bf16_t*)(ws + WS_DL256))[(size_t)lp * 4096 + k] = f2bf(cs ? -ts[r] : tc[r]); }
    for (size_t i = gt; i < (size_t)2048 * 4096 / 2; i += gs) { const int lp = (int)(i >> 11), k = ((int)i & 2047) * 2, cs = k >> 11, l = k & 2047; const int r0 = (lp * l) & 2047, r1 = (lp * (l + 1)) & 2047;
        ((unsigned*)(ws + WS_DL2048))[i] = cs ? cvt_pk_bf16(-ts[r0], -ts[r1]) : cvt_pk_bf16(tc[r0], tc[r1]); }
}

template <bool FINAL>
__device__ void norm_phase(const int g_wid, const Params& p, const float* src_ctx, const float* src_lat, const float* gate  , int np_ctx, int np_lat,
                           const float* g, const float* shp, const float* scp) {
    const int tid_l = LAUNDER_TID(), blk_l = LAUNDER_BLK(); unsigned char* const ws_l = LAUNDER_PTR(p.ws); (void)tid_l; (void)blk_l; (void)ws_l;
    const int lane = tid_l & 63, gw = (blk_l * NT + tid_l) >> 6, nw = (gridDim.x * NT) >> 6;
    float* X = (float*)(ws_l + WS_X); bf16_t* H = (bf16_t*)(ws_l + WS_H); const bf16_t* part = (const bf16_t*)(ws_l + WS_S + S_PART);
    for (int t0 = gw; t0 < NTOK / 2; t0 += nw) {
        f32x4 x[2][4]; u32x2 w[2][4][4]; f32x4 gtv[2][4]; int vecs[2];
#pragma unroll
        for (int q = 0; q < 2; ++q) {
            const int tok = t0 + q * (NTOK / 2);
            vecs[q] = tok < NCTX ? 0 : 1 + ((tok - NCTX) >> 11);
            const float* src = src_ctx ? (tok < NCTX ? src_ctx + (size_t)tok * D : src_lat + (size_t)(tok - NCTX) * D) : X + (size_t)tok * D;
            const int np = tok < NCTX ? np_ctx : np_lat;
#pragma unroll
            for (int u = 0; u < 4; ++u) { const int col = u * 256 + lane * 4; x[q][u] = *(const f32x4*)(src + col);
#pragma unroll
                for (int s = 0; s < 4; ++s) { w[q][u][s] = (u32x2){0u, 0u}; if (s < np) w[q][u][s] = *(const u32x2*)(part + (size_t)s * PART_STRIDE + (size_t)tok * D + col); }
                gtv[q][u] = (f32x4){0.f, 0.f, 0.f, 0.f}; if (np > 0) gtv[q][u] = *(const f32x4*)(gate + vecs[q] * 6144 + col); }
        }
#pragma unroll
        for (int q = 0; q < 2; ++q) {
            const int tok = t0 + q * (NTOK / 2), vec = vecs[q];
            float ss = 0.f;
#pragma unroll
            for (int u = 0; u < 4; ++u) { f32x4 a = {0.f, 0.f, 0.f, 0.f};
#pragma unroll
                for (int s = 0; s < 4; ++s) { a[0] += bf_lo(w[q][u][s][0]); a[1] += bf_hi(w[q][u][s][0]); a[2] += bf_lo(w[q][u][s][1]); a[3] += bf_hi(w[q][u][s][1]); }
                x[q][u] += gtv[q][u] * a;
                ss += x[q][u][0] * x[q][u][0] + x[q][u][1] * x[q][u][1] + x[q][u][2] * x[q][u][2] + x[q][u][3] * x[q][u][3]; }
#pragma unroll
            for (int o = 32; o > 0; o >>= 1) ss += __shfl_xor(ss, o);
            const float rstd = rsqrtf(ss * (1.f / 1024.f) + 1e-6f);
#pragma unroll
            for (int u = 0; u < 4; ++u) { const int col = u * 256 + lane * 4; const f32x4 gg = *(const f32x4*)(g + col);
                if (FINAL) { *(f32x4*)(p.out + (size_t)tok * D + col) = x[q][u] * rstd * gg; }
                else { if (np_ctx + np_lat > 0) *(f32x4*)(X + (size_t)tok * D + col) = x[q][u];
                    const f32x4 sh = *(const f32x4*)(shp + vec * 6144 + col), sc = *(const f32x4*)(scp + vec * 6144 + col);
                    const f32x4 h = x[q][u] * rstd * gg * (sc + 1.f) + sh; u32x2 o; o[0] = cvt_pk_bf16(h[0], h[1]); o[1] = cvt_pk_bf16(h[2], h[3]); *(u32x2*)(H + (size_t)tok * D + col) = o; } }
        }
    }
}

__device__ void gate_phase(const int g_wid, const Params& p, LAS unsigned char* ldsb, int j) {
    const int tid_l = LAUNDER_TID(), blk_l = LAUNDER_BLK(); unsigned char* const ws_l = LAUNDER_PTR(p.ws); (void)tid_l; (void)blk_l; (void)ws_l;
    LAS float* lg = (LAS float*)ldsb;
    LAS unsigned char* lt = ldsb + 8192;
    const int tid = tid_l; unsigned char* S = ws_l + WS_S;
    const bf16_t* Q = (const bf16_t*)(S + S_Q); const bf16_t* K = (const bf16_t*)(S + S_K); const bf16_t* V = (const bf16_t*)(S + S_V); const float* GLR = (const float*)(S + S_GLR);
    for (int unit = blk_l; unit < 256; unit += gridDim.x) {
        const int chunk = unit >> 1, half = unit & 1, tok0 = chunk * 64;
        for (int i = tid; i < 2048; i += NT) lg[i] = GLR[(size_t)tok0 * 32 + i];
        u32x4 vld[8];
#pragma unroll
        for (int tl = 0; tl < 8; ++tl) vld[tl] = *(const u32x4*)(V + (size_t)(tok0 + (tid >> 3)) * 1024 + half * 512 + tl * 64 + (tid & 7) * 8);
        __syncthreads();
        const int dir = __builtin_amdgcn_readfirstlane(tid >> 8), ch = half * 256 + (tid & 255);
        f32x4 w4[4];
#pragma unroll
        for (int r = 0; r < 16; ++r) w4[r >> 2][r & 3] = p.gla_w_g2[(((size_t)j * 2 + dir) * 16 + r) * 512 + ch];
        const float bg = p.gla_b_g[(j * 2 + dir) * 512 + ch];
        bf16_t* Qo = (bf16_t*)(S + (dir ? S_QB : S_QF)); bf16_t* Ko = (bf16_t*)(S + (dir ? S_KB : S_KF)); bf16_t* KTo = (bf16_t*)(S + (dir ? S_KBT : S_KFT));
        float bc = 0.f;
        unsigned short qc[8], kc[8], qn[8], kn[8];
#pragma unroll
        for (int e = 0; e < 8; ++e) { const int tt = dir ? (63 - e) : e; const size_t gi = (size_t)(tok0 + tt) * 512 + ch; qc[e] = Q[gi]; kc[e] = K[gi]; }
#pragma unroll 2
        for (int g8 = 0; g8 < 8; ++g8) {
            if (g8 < 7) {
#pragma unroll
                for (int e = 0; e < 8; ++e) { const int tt = dir ? (63 - ((g8 + 1) * 8 + e)) : ((g8 + 1) * 8 + e); const size_t gi = (size_t)(tok0 + tt) * 512 + ch; qn[e] = Q[gi]; kn[e] = K[gi]; }
            }
            float kt[8];
#pragma unroll
            for (int e = 0; e < 8; ++e) {
                const int tt = dir ? (63 - (g8 * 8 + e)) : (g8 * 8 + e);
                f32x4 lv = *(const LAS f32x4*)(lg + tt * 32 + dir * 16) * w4[0];
#pragma unroll
                for (int r4 = 1; r4 < 4; ++r4) lv += *(const LAS f32x4*)(lg + tt * 32 + dir * 16 + r4 * 4) * w4[r4];
                const float lo = bg + ((lv[0] + lv[1]) + (lv[2] + lv[3]));
                const float ls = fminf(lo, 0.f) - __logf(1.f + __expf(-fabsf(lo)));
                bc += ls * 0.0625f;
                const size_t gi = (size_t)(tok0 + tt) * 512 + ch;
                const float eb = __expf(bc);
                const float qv = bf2f(qc[e]) * eb, kv = bf2f(kc[e]) * __builtin_amdgcn_rcpf(eb);
                Qo[gi] = f2bf(qv); Ko[gi] = f2bf(kv); kt[e] = kv;
            }
            const int t8 = dir ? (7 - g8) : g8;
            u32x4 o;
            if (dir) { o[0] = cvt_pk_bf16(kt[7], kt[6]); o[1] = cvt_pk_bf16(kt[5], kt[4]); o[2] = cvt_pk_bf16(kt[3], kt[2]); o[3] = cvt_pk_bf16(kt[1], kt[0]); }
            else { o[0] = cvt_pk_bf16(kt[0], kt[1]); o[1] = cvt_pk_bf16(kt[2], kt[3]); o[2] = cvt_pk_bf16(kt[4], kt[5]); o[3] = cvt_pk_bf16(kt[6], kt[7]); }
            *(u32x4*)(KTo + ((size_t)chunk * 512 + ch) * 64 + t8 * 8) = o;
#pragma unroll
            for (int e = 0; e < 8; ++e) { qc[e] = qn[e]; kc[e] = kn[e]; }
        }
        ((float*)(S + S_EE))[((size_t)dir * 128 + chunk) * 512 + ch] = __expf(bc);
        { bf16_t* VT = (bf16_t*)(S + S_VT);
#pragma unroll
          for (int tl = 0; tl < 8; ++tl) {
              __syncthreads();
              { LAS unsigned* d = (LAS unsigned*)(lt + (tid >> 3) * 132 + (tid & 7) * 16); d[0] = vld[tl][0]; d[1] = vld[tl][1]; d[2] = vld[tl][2]; d[3] = vld[tl][3]; }
              __syncthreads();
              const int dv = tid >> 3, t8 = tid & 7; unsigned short vv[8];
#pragma unroll
              for (int e = 0; e < 8; ++e) vv[e] = *(const LAS unsigned short*)(lt + (t8 * 8 + e) * 132 + dv * 2);
              u32x4 o; o[0] = vv[0] | ((unsigned)vv[1] << 16); o[1] = vv[2] | ((unsigned)vv[3] << 16); o[2] = vv[4] | ((unsigned)vv[5] << 16); o[3] = vv[6] | ((unsigned)vv[7] << 16);
              *(u32x4*)(VT + ((size_t)chunk * 1024 + half * 512 + tl * 64 + dv) * 64 + t8 * 8) = o; } }
        __syncthreads();
    }
}

template <int NDT>
__device__ __forceinline__ void scan_unit(const Params& p, LAS unsigned char* lds, unsigned char* S, const int j, const bool lat, const int b, const int h, const int dir, const int slice,
                                          const int tid, const int w, const int r, const int q) {
    constexpr int LQ = 0, LK = 17408, LKT = 34816, LVT = 53248, OPB = 62464, LST = 2 * OPB, LAT = LST + 17408, LE = LAT + 9216;
    static_assert(LE + 1024 <= LDS_TOP, "scan LDS image");
    constexpr int DVS = 16 * NDT, TPW = NDT / 2;
    const int nc = lat ? 32 : 4, tokbase = lat ? NCTX + b * 2048 : b * 256, chunk0 = tokbase >> 6;
    const bf16_t* Qs = (const bf16_t*)(S + (dir ? S_QB : S_QF)); const bf16_t* Ks = (const bf16_t*)(S + (dir ? S_KB : S_KF));
    const bf16_t* KTs = (const bf16_t*)(S + (dir ? S_KBT : S_KFT)); const bf16_t* VTs = (const bf16_t*)(S + S_VT);
    const float* Es = (const float*)(S + S_EE) + (size_t)dir * 128 * 512;
    bf16_t* O = (bf16_t*)(S + (dir ? S_OB : S_OF));
    f32x4 acc[NDT];
#pragma unroll
    for (int nd = 0; nd < NDT; ++nd) {
#pragma unroll
        for (int jj = 0; jj < 4; ++jj) { const int kk = w * 16 + q * 4 + jj, dv = nd * 16 + r;
            acc[nd][jj] = lat ? p.state_gla[((((size_t)(b * 2 + j) * 2 + dir) * 4 + h) * 128 + kk) * 256 + slice * DVS + dv] : 0.f; }
        u32x2 o; o[0] = cvt_pk_bf16(acc[nd][0], acc[nd][1]); o[1] = cvt_pk_bf16(acc[nd][2], acc[nd][3]);
        *(LAS u32x2*)(lds + LST + (nd * 16 + r) * 272 + (w * 16 + q * 4) * 2) = o;
    }
    u32x4 pq[2], pk[2], pkt[2], pvt = {0u, 0u, 0u, 0u}; float pe = 0.f;
#define SCAN_LOAD(s_) do { const int cgl_ = chunk0 + (dir ? nc - 1 - (s_) : (s_)); const size_t t0_ = (size_t)cgl_ * 64; \
    _Pragma("unroll") for (int u = 0; u < 2; ++u) { const int i = (tid >> 4) + 32 * u, pc = tid & 15; \
        pq[u] = *(const u32x4*)(Qs + (t0_ + i) * 512 + h * 128 + pc * 8); pk[u] = *(const u32x4*)(Ks + (t0_ + i) * 512 + h * 128 + pc * 8); \
        pkt[u] = *(const u32x4*)(KTs + ((size_t)cgl_ * 512 + h * 128) * 64 + (size_t)(tid + 512 * u) * 8); } \
    if (tid < DVS * 8) pvt = *(const u32x4*)(VTs + ((size_t)cgl_ * 1024 + h * 256 + slice * DVS) * 64 + (size_t)tid * 8); \
    if (tid < 128) pe = Es[(size_t)cgl_ * 512 + h * 128 + tid]; } while (0)
#define SCAN_WRITE(ob_) do { LAS unsigned char* const lb_ = lds + (ob_) * OPB; \
    _Pragma("unroll") for (int u = 0; u < 2; ++u) { const int i = (tid >> 4) + 32 * u, pc = tid & 15; \
        *(LAS u32x4*)(lb_ + LQ + i * 272 + pc * 16) = pq[u]; *(LAS u32x4*)(lb_ + LK + i * 272 + pc * 16) = pk[u]; \
        const int id2 = tid + 512 * u; *(LAS u32x4*)(lb_ + LKT + (id2 >> 3) * 144 + (id2 & 7) * 16) = pkt[u]; } \
    if (tid < DVS * 8) *(LAS u32x4*)(lb_ + LVT + (tid >> 3) * 144 + (tid & 7) * 16) = pvt; \
    if (tid < 128) *(LAS float*)(lds + LE + (ob_) * 512 + tid * 4) = pe; } while (0)
    SCAN_LOAD(0);
    SCAN_WRITE(0);
    __syncthreads();
    for (int s = 0; s < nc; ++s) {
        const int cur = s & 1; LAS unsigned char* const lb = lds + cur * OPB;
        const int cgl = chunk0 + (dir ? nc - 1 - s : s); const size_t tok0 = (size_t)cgl * 64;
        if (s + 1 < nc) SCAN_LOAD(s + 1);
        const int mi = w >> 1, n0 = 2 * (w & 1), d0 = TPW * (w & 1);
        const f32x4 e4 = *(const LAS f32x4*)(lds + LE + cur * 512 + (w * 16 + q * 4) * 4);
        bf16x8 qa[4];
        {
            bf16x8 kb[2][4], ka[2], vb[NDT][2];
#pragma unroll
            for (int ks = 0; ks < 4; ++ks) { qa[ks] = *(const LAS bf16x8*)(lb + LQ + (mi * 16 + r) * 272 + (ks * 32 + q * 8) * 2);
#pragma unroll
                for (int t = 0; t < 2; ++t) kb[t][ks] = *(const LAS bf16x8*)(lb + LK + ((n0 + t) * 16 + r) * 272 + (ks * 32 + q * 8) * 2); }
#pragma unroll
            for (int ks = 0; ks < 2; ++ks) { ka[ks] = *(const LAS bf16x8*)(lb + LKT + (w * 16 + r) * 144 + (ks * 32 + q * 8) * 2);
#pragma unroll
                for (int nd = 0; nd < NDT; ++nd) vb[nd][ks] = *(const LAS bf16x8*)(lb + LVT + (nd * 16 + r) * 144 + (ks * 32 + q * 8) * 2); }
            f32x4 at[2] = {{0.f, 0.f, 0.f, 0.f}, {0.f, 0.f, 0.f, 0.f}};
#pragma unroll
            for (int ks = 0; ks < 4; ++ks)
#pragma unroll
                for (int t = 0; t < 2; ++t) at[t] = __builtin_amdgcn_mfma_f32_16x16x32_bf16(kb[t][ks], qa[ks], at[t], 0, 0, 0);
#pragma unroll
            for (int ks = 0; ks < 2; ++ks)
#pragma unroll
                for (int nd = 0; nd < NDT; ++nd) acc[nd] = __builtin_amdgcn_mfma_f32_16x16x32_bf16(ka[ks], vb[nd][ks], acc[nd], 0, 0, 0);
#pragma unroll
            for (int t = 0; t < 2; ++t) { const int i = mi * 16 + r, j0 = (n0 + t) * 16 + q * 4; float v[4];
#pragma unroll
                for (int jj = 0; jj < 4; ++jj) { const bool keep = dir ? (j0 + jj >= i) : (j0 + jj <= i); v[jj] = keep ? at[t][jj] : 0.f; }
                u32x2 o; o[0] = cvt_pk_bf16(v[0], v[1]); o[1] = cvt_pk_bf16(v[2], v[3]);
                *(LAS u32x2*)(lds + LAT + i * 144 + j0 * 2) = o; }
        }
        __syncthreads();
        {
            bf16x8 aa[2], vb2[TPW][2], sb[TPW][4];
#pragma unroll
            for (int ks = 0; ks < 2; ++ks) { aa[ks] = *(const LAS bf16x8*)(lds + LAT + (mi * 16 + r) * 144 + (ks * 32 + q * 8) * 2);
#pragma unroll
                for (int t = 0; t < TPW; ++t) vb2[t][ks] = *(const LAS bf16x8*)(lb + LVT + ((d0 + t) * 16 + r) * 144 + (ks * 32 + q * 8) * 2); }
#pragma unroll
            for (int ks = 0; ks < 4; ++ks)
#pragma unroll
                for (int t = 0; t < TPW; ++t) sb[t][ks] = *(const LAS bf16x8*)(lds + LST + ((d0 + t) * 16 + r) * 272 + (ks * 32 + q * 8) * 2);
            f32x4 oo[TPW];
#pragma unroll
            for (int t = 0; t < TPW; ++t) oo[t] = (f32x4){0.f, 0.f, 0.f, 0.f};
#pragma unroll
            for (int ks = 0; ks < 4; ++ks)
#pragma unroll
                for (int t = 0; t < TPW; ++t) oo[t] = __builtin_amdgcn_mfma_f32_16x16x32_bf16(sb[t][ks], qa[ks], oo[t], 0, 0, 0);
#pragma unroll
            for (int ks = 0; ks < 2; ++ks)
#pragma unroll
                for (int t = 0; t < TPW; ++t) oo[t] = __builtin_amdgcn_mfma_f32_16x16x32_bf16(vb2[t][ks], aa[ks], oo[t], 0, 0, 0);
#pragma unroll
            for (int t = 0; t < TPW; ++t) { u32x2 o; o[0] = cvt_pk_bf16(oo[t][0], oo[t][1]); o[1] = cvt_pk_bf16(oo[t][2], oo[t][3]);
                *(u32x2*)(O + (tok0 + mi * 16 + r) * 1024 + h * 256 + slice * DVS + (d0 + t) * 16 + q * 4) = o; }
        }
        if (s + 1 < nc) SCAN_WRITE(cur ^ 1);
        __syncthreads();
#pragma unroll
        for (int nd = 0; nd < NDT; ++nd) { acc[nd] = acc[nd] * e4;
            u32x2 o; o[0] = cvt_pk_bf16(acc[nd][0], acc[nd][1]); o[1] = cvt_pk_bf16(acc[nd][2], acc[nd][3]);
            *(LAS u32x2*)(lds + LST + (nd * 16 + r) * 272 + (w * 16 + q * 4) * 2) = o; }
    }
    if (!lat) {
        float* so = p.out + 2 * (size_t)NCTX * D;
#pragma unroll
        for (int nd = 0; nd < NDT; ++nd)
#pragma unroll
            for (int jj = 0; jj < 4; ++jj) { const int kk = w * 16 + q * 4 + jj, dv = nd * 16 + r;
                so[((((size_t)(b * 2 + j) * 2 + dir) * 4 + h) * 128 + kk) * 256 + slice * DVS + dv] = acc[nd][jj]; }
    }
    __syncthreads();
#undef SCAN_LOAD
#undef SCAN_WRITE
}
__device__ void scan_phase(const int g_wid, const Params& p, LAS unsigned char* lds, int j) {
    const int tid_l = LAUNDER_TID(), blk_l = LAUNDER_BLK(); unsigned char* const ws_l = LAUNDER_PTR(p.ws); (void)tid_l; (void)blk_l; (void)ws_l;
    const int tid = tid_l, w = __builtin_amdgcn_readfirstlane(tid >> 6), lane = tid & 63, r = lane & 15, q = lane >> 4;
    unsigned char* S = ws_l + WS_S;
    const int blk = blk_l, G = gridDim.x;
    for (int kq = 0;; ++kq) {
        const int ul = (G == 256) ? (blk < 128 ? (kq == 0 ? blk : 640) : blk + 128 * kq) : blk + kq * G;
        if (ul >= 640) break;
        if (ul < 128) { const int slice = ul & 7, dir = (ul >> 3) & 1, h = (ul >> 4) & 3, b = ul >> 6; scan_unit<2>(p, lds, S, j, true, b, h, dir, slice, tid, w, r, q); }
        else { const int idx = ul - 128, slice = idx & 3, dir = (idx >> 2) & 1, h = (idx >> 3) & 3, b = idx >> 5; scan_unit<4>(p, lds, S, j, false, b, h, dir, slice, tid, w, r, q); }
    }
}

__device__ void onorm_phase(const int g_wid, const Params& p, int j) {
    const int tid_l = LAUNDER_TID(), blk_l = LAUNDER_BLK(); unsigned char* const ws_l = LAUNDER_PTR(p.ws); (void)tid_l; (void)blk_l; (void)ws_l;
    const int lane = tid_l & 63, gw = (blk_l * NT + tid_l) >> 6, nw = (gridDim.x * NT) >> 6;
    unsigned char* S = ws_l + WS_S; const bf16_t* OF = (const bf16_t*)(S + S_OF); const bf16_t* OB = (const bf16_t*)(S + S_OB); const bf16_t* R = (const bf16_t*)(S + S_R);
    bf16_t* H = (bf16_t*)(ws_l + WS_H);
    const f32x4 ng = *(const f32x4*)(p.gla_norm_g + j * 256 + lane * 4);
    for (int it0 = gw; it0 < NTOK * 4; it0 += 4 * nw) {
        u32x2 a[4], b[4], rr[4]; size_t off[4]; bool ok[4];
#pragma unroll
        for (int k = 0; k < 4; ++k) { const int it = it0 + k * nw; ok[k] = it < NTOK * 4; off[k] = (size_t)(ok[k] ? it : 0) * 256 + lane * 4;
            a[k] = *(const u32x2*)(OF + off[k]); b[k] = *(const u32x2*)(OB + off[k]); rr[k] = *(const u32x2*)(R + off[k]); }
#pragma unroll
        for (int k = 0; k < 4; ++k) {
            f32x4 o = {bf_lo(a[k][0]) + bf_lo(b[k][0]), bf_hi(a[k][0]) + bf_hi(b[k][0]), bf_lo(a[k][1]) + bf_lo(b[k][1]), bf_hi(a[k][1]) + bf_hi(b[k][1])};
            float ss = o[0] * o[0] + o[1] * o[1] + o[2] * o[2] + o[3] * o[3];
#pragma unroll
            for (int x = 32; x > 0; x >>= 1) ss += __shfl_xor(ss, x);
            const float rstd = rsqrtf(ss * (1.f / 256.f) + 1e-6f);
            const f32x4 rv = {silu_f(bf_lo(rr[k][0])), silu_f(bf_hi(rr[k][0])), silu_f(bf_lo(rr[k][1])), silu_f(bf_hi(rr[k][1]))};
            const f32x4 y = o * rstd * ng * rv;
            u32x2 out; out[0] = cvt_pk_bf16(y[0], y[1]); out[1] = cvt_pk_bf16(y[2], y[3]); if (ok[k]) *(u32x2*)(H + off[k]) = out;
        }
    }
}

__device__ void convact_phase(const int g_wid, const Params& p, int layer) {
    const int tid_l = LAUNDER_TID(), blk_l = LAUNDER_BLK(); unsigned char* const ws_l = LAUNDER_PTR(p.ws); (void)tid_l; (void)blk_l; (void)ws_l;
    unsigned char* S = ws_l + WS_S; const bf16_t* A = (const bf16_t*)(S + S_UPA); const bf16_t* Gt = (const bf16_t*)(S + S_UPG); bf16_t* ACT = (bf16_t*)(S + S_ACT);
    const float* cw = p.ffn_conv_w + (size_t)layer * 3 * FFN; const float* cb = p.ffn_conv_b + (size_t)layer * FFN;
    const size_t gt = (size_t)blk_l * NT + tid_l, gs = (size_t)gridDim.x * NT;
    for (size_t it = gt; it < (size_t)512 * 352; it += gs) {
        const int seg = (int)(it / 352), c0 = (int)(it % 352) * 8, tok0 = seg * 16;
        const int lenm1 = tok0 < NCTX ? 255 : 63;
        f32x4 w0[2], w1[2], w2[2], bb[2];
#pragma unroll
        for (int h2 = 0; h2 < 2; ++h2) { w0[h2] = *(const f32x4*)(cw + c0 + 4 * h2); w1[h2] = *(const f32x4*)(cw + FFN + c0 + 4 * h2); w2[h2] = *(const f32x4*)(cw + 2 * FFN + c0 + 4 * h2); bb[h2] = *(const f32x4*)(cb + c0 + 4 * h2); }
        const u32x4 z = {0u, 0u, 0u, 0u};
        size_t off = (size_t)tok0 * FFN + c0;
        u32x4 prev = (tok0 & lenm1) > 0 ? *(const u32x4*)(A + off - FFN) : z, cur = *(const u32x4*)(A + off);
#pragma unroll 4
        for (int t = 0; t < 16; ++t, off += FFN) {
            const int pos = (tok0 + t) & lenm1;
            const u32x4 nxt = pos < lenm1 ? *(const u32x4*)(A + off + FFN) : z, gg = *(const u32x4*)(Gt + off);
            u32x4 o;
#pragma unroll
            for (int e = 0; e < 4; ++e) { const int h2 = e >> 1, x = (e & 1) * 2;
                const float v0 = bf_lo(prev[e]) * w0[h2][x] + bf_lo(cur[e]) * w1[h2][x] + bf_lo(nxt[e]) * w2[h2][x] + bb[h2][x];
                const float v1 = bf_hi(prev[e]) * w0[h2][x + 1] + bf_hi(cur[e]) * w1[h2][x + 1] + bf_hi(nxt[e]) * w2[h2][x + 1] + bb[h2][x + 1];
                o[e] = cvt_pk_bf16(silu_f(v0) * bf_lo(gg[e]), silu_f(v1) * bf_hi(gg[e])); }
            *(u32x4*)(ACT + off) = o;
            prev = cur; cur = nxt;
        }
    }
}

constexpr int N_PHASES = 1 + 11 + 6 + 9 + 6 + 1;
__device__ __forceinline__ void decode_phase(int ph, int& layer, int& kind) {
    if (ph == 0) { layer = 0; kind = 0; return; }
    ph -= 1;
    if (ph < 11) { layer = 0; kind = ph == 0 ? 10 : ph == 1 ? 11 : ph == 2 ? 1 : ph <= 6 ? 9 + ph : ph == 7 ? 30 : ph == 8 ? 31 : ph == 9 ? 2 : 33; return; }
    if (ph < 17) { layer = 1; ph -= 11; } else if (ph < 26) { layer = 2; ph -= 17; } else if (ph < 32) { layer = 3; ph -= 26; } else { layer = 4; kind = 40; return; }
    if ((layer & 1) == 0) kind = ph < 6 ? 10 + ph : (ph == 6 ? 30 : ph == 7 ? 31 : 33);
    else kind = ph == 0 ? 10 : (ph < 3 ? 19 + ph : (ph == 3 ? 30 : ph == 4 ? 31 : 33));
}

__global__ void __launch_bounds__(NT, 2) fwd_kernel(Params p) {
    extern __shared__ __attribute__((aligned(16))) unsigned char shm[];
    LAS unsigned char* lds = (LAS unsigned char*)shm;
    const int tid = threadIdx.x, G = gridDim.x; const int g_wid = __builtin_amdgcn_readfirstlane(tid >> 6);
    volatile LAS unsigned* st = (volatile LAS unsigned*)(lds + LDS_TOP);
    if (tid < 4) st[tid] = 0u;
    __syncthreads();
    XcdBarrier bar; bar.bar = (unsigned*)(p.ws + WS_CTL); bar.x = 0; bar.st = st;
    const bool multi = (p.ph_hi - p.ph_lo) > 1;
    if (multi) bar = xcd_barrier_post((unsigned*)(p.ws + WS_CTL), st);
    if (p.never) cg::this_grid().sync();
    int repdone = 0; (void)repdone;
    for (int ph = p.ph_lo; ph < p.ph_hi; ++ph) {
        int layer, kind; decode_phase(ph, layer, kind);
        unsigned char* const ws = LAUNDER_PTR(p.ws); unsigned char* const S = ws + WS_S; const int c = LAUNDER_BLK();
        const int j = layer >> 1;
        const float* MODV = (const float*)(ws + WS_MODV); const float* mv = MODV + (size_t)layer * 3 * 6144;
        bool is_gemm = true; GSched Sd{}; Sd.G = G; Sd.c = c; Sd.lda = 2048; Sd.ldb = 2048;
        switch (kind) {
        case 1: Sd.c = G - 1 - c; Sd.kind = 4; Sd.A = (const char*)(ws + WS_WINB); Sd.B = (const char*)(ws + WS_CW); Sd.ldb = 512; Sd.nt = 4; Sd.o0 = (bf16_t*)(ws + WS_T1); break;
        case 2: Sd.c = G - 1 - c; Sd.kind = 5; Sd.A = (const char*)(ws + WS_WOT); Sd.B = (const char*)(ws + WS_T1); Sd.nt = 16; Sd.o0 = (bf16_t*)(ws + WS_WCS); break;
        case 11: Sd.kind = 0; Sd.A = (const char*)(ws + WS_H); Sd.B = (const char*)(ws + WS_WGIN) + (size_t)j * GINP * 2048; Sd.nM = 32; Sd.nN = 13; Sd.nt = 16; Sd.o0 = (bf16_t*)S; break;
        case 15: Sd.kind = 3; Sd.A = (const char*)(ws + WS_H); Sd.B = (const char*)(ws + WS_WGO) + (size_t)j * 2 * MB; Sd.nt = 8; Sd.koff = 1024; Sd.o0 = (bf16_t*)(S + S_PART); break;
        case 20: Sd.kind = 2; Sd.A = (const char*)(ws + WS_WCS) + (size_t)j * 4 * MB; Sd.B = (const char*)(ws + WS_H); Sd.nM = 8; Sd.nN = 32; Sd.nt = 16;
            Sd.o0 = (bf16_t*)(S + S_HWTC); Sd.o1 = (bf16_t*)(S + S_HWTL); break;
        case 21: Sd.kind = 6; Sd.A = (const char*)(ws + WS_DL2048); Sd.B = (const char*)(S + S_HWTL); Sd.A2 = (const char*)(ws + WS_DL256); Sd.B2 = (const char*)(S + S_HWTC); Sd.lda = 8192; Sd.ldb = 16384;
            Sd.o0 = (bf16_t*)(S + S_PART); break;
        case 31: Sd.kind = 1; Sd.A = (const char*)(ws + WS_H); Sd.B = (const char*)(ws + WS_WUP) + (size_t)layer * 2 * FFN * 2048; Sd.nM = 32; Sd.nN = 22; Sd.nt = 16;
            Sd.o0 = (bf16_t*)(S + S_ACT); Sd.cw = p.ffn_conv_w + (size_t)layer * 3 * FFN; Sd.cb = p.ffn_conv_b + (size_t)layer * FFN; break;
        case 33: Sd.kind = 3; Sd.A = (const char*)(S + S_ACT); Sd.B = (const char*)(ws + WS_WDN) + (size_t)layer * 1024 * FFN * 2; Sd.lda = FFN * 2; Sd.ldb = FFN * 2; Sd.nt = 22; Sd.koff = 1408 * 2;
            Sd.o0 = (bf16_t*)(S + S_PART); break;
        default: is_gemm = false; break;
        }
        if (is_gemm) pg8::gemm_phase(g_wid, lds, Sd.lda, Sd.ldb, Sd);
        else switch (kind) {
        case 0: setup_phase(g_wid, p, lds); break;
        case 10:
            if (layer == 0) norm_phase<false>(g_wid, p, p.x_prompt, p.x_sample, nullptr, 0, 0, p.norm_mix_g, mv + 0, mv + 1024);
            else norm_phase<false>(g_wid, p, nullptr, nullptr, MODV + (size_t)(layer - 1) * 3 * 6144 + 5 * 1024, 2, 2, p.norm_mix_g + layer * 1024, mv + 0, mv + 1024);
            break;
        case 12: gate_phase(g_wid, p, lds, j); break;
        case 13: scan_phase(g_wid, p, lds, j); break;
        case 14: onorm_phase(g_wid, p, j); break;
        case 30: { const bool gla = (layer & 1) == 0;
            norm_phase<false>(g_wid, p, layer == 0 ? p.x_prompt : nullptr, layer == 0 ? p.x_sample : nullptr, mv + 2 * 1024, 2, gla ? 2 : 4, p.norm_ffn_g + layer * 1024, mv + 3 * 1024, mv + 4 * 1024); } break;
        case 40: norm_phase<true>(g_wid, p, nullptr, nullptr, MODV + (size_t)3 * 3 * 6144 + 5 * 1024, 2, 2, p.final_norm_g, nullptr, nullptr); break;
        default: break;
        }
        if (ph + 1 < p.ph_hi && ph != 2 && ph != 9) xcd_barrier(g_wid, bar);
#if REP_MASK
        if (!repdone && (((REP_MASK & 1) && is_gemm) || ((REP_MASK & 2) && kind == 13) || ((REP_MASK & 4) && kind == 0) || ((REP_MASK & 8) && (kind == 12 || kind == 14 || kind == 32)) || ((REP_MASK & 16) && kind == 12) || ((REP_MASK & 32) && kind == 14) || ((REP_MASK & 64) && kind == 32) || ((REP_MASK & 128) && kind == 33) || ((REP_MASK & 256) && kind == 31) || ((REP_MASK & 512) && kind == 11))) { repdone = 1; --ph; } else repdone = 0;
#endif
    }
}


#ifdef DBG_STOP
struct DbgBuf { size_t off; size_t n; int f32; int inS; };
__global__ void dbg_check(Params p, unsigned* flag) {
    const DbgBuf bufs[] = { {S_OF, 4194304, 0, 1} };
    const int nb = sizeof(bufs) / sizeof(bufs[0]);
    const size_t gt = (size_t)blockIdx.x * blockDim.x + threadIdx.x, gs = (size_t)gridDim.x * blockDim.x;
    for (int b = 0; b < nb && b < DBG_NBUF; ++b) {
        const unsigned char* base = p.ws + (bufs[b].inS ? WS_S : 0) + bufs[b].off; bool bad = false;
        if (bufs[b].f32) { const unsigned* q = (const unsigned*)base; for (size_t i = gt; i < bufs[b].n; i += gs) { const unsigned v = q[i]; if (v == 0xAAAAAAAAu) bad = true; } }
        else { const unsigned short* q = (const unsigned short*)base; unsigned cnt = 0; for (size_t i = gt; i < bufs[b].n; i += gs) { const unsigned short v = q[i]; if (v == 0xAAAAu) ++cnt; } if (cnt) atomicAdd(flag, cnt); }


    }
}
__global__ void dbg_fill(float* out, const unsigned* flag, size_t n_all, size_t n_first) {
    const unsigned f = *flag; const float c1 = 2.f * floorf(log2f(1.f + (float)f)), c2 = c1;
    for (size_t i = (size_t)blockIdx.x * blockDim.x + threadIdx.x; i < n_all; i += (size_t)gridDim.x * blockDim.x) out[i] = i < n_first / 2 ? c1 : (i < n_first ? c2 : 0.f);
}
#endif

extern "C" void kernel_launch(void* const* d_in, const int* in_sizes, int n_in, void* d_out, int out_size, void* d_ws, size_t ws_size, hipStream_t stream) {
    static int grid = 0;
    if (grid == 0) {
        if (n_in != 21 || ws_size < WS_END) { fprintf(stderr, "kernel_launch: unexpected n_in %d or ws_size %zu (< %zu)\n", n_in, ws_size, (size_t)WS_END); grid = -1; return; }
        int dev = 0, cus = 0, per_cu = 0;
        hipGetDevice(&dev); hipDeviceGetAttribute(&cus, hipDeviceAttributeMultiprocessorCount, dev);
        if (hipFuncSetAttribute((const void*)fwd_kernel, hipFuncAttributeMaxDynamicSharedMemorySize, LDS_BYTES) != hipSuccess) { fprintf(stderr, "kernel_launch: hipFuncSetAttribute failed\n"); grid = -1; return; }
        hipOccupancyMaxActiveBlocksPerMultiprocessor(&per_cu, (const void*)fwd_kernel, NT, LDS_BYTES);
        if (per_cu < 1) { fprintf(stderr, "kernel_launch: occupancy query says %d\n", per_cu); per_cu = 1; }
        (void)hipGetLastError();
        grid = cus;
    }
    if (grid < 0) return;
    Params p{};
    const float** pp = (const float**)&p;
    for (int i = 0; i < 21; ++i) pp[i] = (const float*)d_in[i];
    p.out = (float*)d_out; p.ws = (unsigned char*)d_ws; p.never = 0; p.pad = 0;
    hipMemsetAsync((char*)d_ws + WS_CTL, 0, 16384, stream);
#if ONE_LAUNCH
    p.ph_lo = 0; p.ph_hi = N_PHASES;
    void* args[] = {&p};
    hipError_t e = hipLaunchCooperativeKernel((const void*)fwd_kernel, dim3(grid), dim3(NT), args, LDS_BYTES, stream);
    if (e != hipSuccess) fprintf(stderr, "cooperative launch failed: %s (grid %d)\n", hipGetErrorString(e), grid);
#else
#ifdef DBG_STOP
    for (int ph = 0; ph < DBG_STOP; ++ph) { p.ph_lo = ph; p.ph_hi = ph + 1; hipLaunchKernelGGL(fwd_kernel, dim3(grid), dim3(NT), LDS_BYTES, stream, p); }

    unsigned* flag = (unsigned*)((char*)d_ws + WS_CTL + 15360);
    hipMemsetAsync(flag, 0, 4, stream);
    hipLaunchKernelGGL(dbg_check, dim3(1024), dim3(256), 0, stream, p, flag);
    hipLaunchKernelGGL(dbg_fill, dim3(1024), dim3(256), 0, stream, (float*)d_out, flag, (size_t)out_size, (size_t)NCTX * D);
#else
    for (int ph = 0; ph < N_PHASES; ++ph) { p.ph_lo = ph; p.ph_hi = ph + 1; hipLaunchKernelGGL(fwd_kernel, dim3(grid), dim3(NT), LDS_BYTES, stream, p); }
#endif
#endif
}
```

```cpp
#include <hip/hip_runtime.h>
#include <hip/hip_cooperative_groups.h>
#include <cstdio>
#include <cstdint>
namespace cg = cooperative_groups;

#ifndef REP_MASK
#define REP_MASK 0
#endif
#ifndef ONE_LAUNCH
#define ONE_LAUNCH 1
#endif

#define LAS __attribute__((address_space(3)))
typedef unsigned short bf16_t;
typedef short bf16x8 __attribute__((ext_vector_type(8)));
typedef float f32x4 __attribute__((ext_vector_type(4)));
typedef unsigned u32x4 __attribute__((ext_vector_type(4)));
typedef unsigned u32x2 __attribute__((ext_vector_type(2)));

#define LAUNDER_TID() ({ int _t = (g_wid << 6) | (int)__builtin_amdgcn_mbcnt_hi(~0u, __builtin_amdgcn_mbcnt_lo(~0u, 0u)); asm volatile("" : "+v"(_t)); _t; })
#define LAUNDER_BLK() ({ int _b = blockIdx.x; asm volatile("" : "+s"(_b)); _b; })
#define LAUNDER_PTR(x) ({ size_t _z = 0; asm volatile("" : "+s"(_z)); (x) + _z; })
constexpr int D = 1024, NTOK = 8192, NCTX = 4096, FFN = 2816, GIN = 3104, GINP = 3328;
constexpr int NT = 512;
constexpr size_t MB = 1024 * 1024;
constexpr size_t WS_CTL = 0, WS_MODV = 64 * 1024, WS_X = 1 * MB, WS_H = 33 * MB, WS_WGIN = 49 * MB, WS_WGO = 62 * MB, WS_WINB = 66 * MB,
                 WS_WOT = 70 * MB, WS_T1 = 74 * MB, WS_WCS = 82 * MB, WS_WUP = 90 * MB, WS_WDN = 134 * MB, WS_CW = 156 * MB, WS_DL256 = 157 * MB,
                 WS_DL2048 = 159 * MB, WS_S = 175 * MB, WS_END = 325 * MB;
constexpr size_t S_UPA = 0, S_UPG = 44 * MB, S_ACT = 88 * MB, S_PART = 0, S_Q = 0, S_K = 8 * MB, S_V = 16 * MB, S_R = 32 * MB, S_GLR = 48 * MB,
                 S_QF = 49 * MB, S_KF = 57 * MB, S_QB = 65 * MB, S_KB = 73 * MB, S_KFT = 81 * MB, S_KBT = 89 * MB, S_VT = 97 * MB, S_EE = 113 * MB,
                 S_OF = 114 * MB, S_OB = 130 * MB, S_HWTC = 80 * MB, S_HWTL = 96 * MB;
constexpr size_t PART_STRIDE = (size_t)NTOK * D;
constexpr int LDS_STAGE = 131072, LDS_TOP = 152576  , LDS_XB = LDS_TOP + 256  , LDS_BYTES = LDS_XB + 4096;

struct Params {
    const float *x_prompt, *x_sample, *state_gla, *c, *c_ctx, *norm_mix_g, *norm_ffn_g, *w_mod, *b_mod, *gla_w_in, *gla_w_g2, *gla_b_g, *gla_norm_g,
        *gla_w_o, *fnet_w_in, *fnet_w_o, *ffn_w_up, *ffn_conv_w, *ffn_conv_b, *ffn_w_down, *final_norm_g;
    float* out; unsigned char* ws; int ph_lo, ph_hi, never, pad;
};

typedef __bf16 bf16v2_t __attribute__((ext_vector_type(2)));
typedef float f32v2_t __attribute__((ext_vector_type(2)));
__device__ __forceinline__ unsigned cvt_pk_bf16(float lo, float hi) { const f32v2_t v = {lo, hi}; const bf16v2_t b = __builtin_convertvector(v, bf16v2_t); return __builtin_bit_cast(unsigned, b); }
__device__ __forceinline__ bf16_t f2bf(float f) { return (bf16_t)(cvt_pk_bf16(f, 0.f) & 0xffffu); }
__device__ __forceinline__ float bf_lo(unsigned u) { return __uint_as_float(u << 16); }
__device__ __forceinline__ float bf_hi(unsigned u) { return __uint_as_float(u & 0xffff0000u); }
__device__ __forceinline__ float bf2f(bf16_t b) { return __uint_as_float(((unsigned)b) << 16); }
__device__ __forceinline__ float silu_f(float x) { return x / (1.f + __expf(-x)); }

#define XB_TMO      128
#define XB_XCNT(j)  (256  + 64 * (j))
#define XB_XSUB(j)  (1280 + 64 * (j))
#define XB_XGEN(j)  (2304 + 64 * (j))
#define XB_TOP      3328
#define XB_TOPGEN   3392
#define XCD_BAR_WORDS 3456
#define XB_SPIN_CAP (1u << 20)
__device__ __forceinline__ unsigned xb_ld(unsigned* p)              { return __hip_atomic_load(p, __ATOMIC_RELAXED, __HIP_MEMORY_SCOPE_AGENT); }
__device__ __forceinline__ unsigned xb_add(unsigned* p, unsigned v) { return __hip_atomic_fetch_add(p, v, __ATOMIC_RELAXED, __HIP_MEMORY_SCOPE_AGENT); }
__device__ __forceinline__ unsigned xb_xcc_id() { return (unsigned)__builtin_amdgcn_s_getreg((3 << 11) | 20) & 0xFu; }
#define XB_SPIN(cond, bar) do { unsigned _sp = 0; while (cond) { __builtin_amdgcn_s_sleep(1); \
    if ((++_sp & 255u) == 0u) { if (xb_ld(&(bar)[XB_TMO])) break; if (_sp > XB_SPIN_CAP) { atomicAdd(&(bar)[XB_TMO], 1u); break; } } } } while (0)
struct XcdBarrier { unsigned* bar; unsigned x; volatile LAS unsigned* st; };
__device__ __forceinline__ XcdBarrier xcd_barrier_post(unsigned* bar, volatile LAS unsigned* st) {
    XcdBarrier b; b.bar = bar; b.x = xb_xcc_id(); b.st = st;
    if (threadIdx.x == 0) (void)xb_add(&bar[XB_XCNT(b.x)], 1u);
    return b;
}
__device__ __forceinline__ void xcd_barrier_complete(unsigned* bar, unsigned x, unsigned& nloc, unsigned& nx) {
    const unsigned G = gridDim.x * gridDim.y * gridDim.z;
    unsigned sum, cnt, mine, sp = 0u;
    for (;;) {
        sum = 0u; cnt = 0u; mine = 0u;
#pragma unroll
        for (unsigned j = 0; j < 16; ++j) { const unsigned c = xb_ld(&bar[XB_XCNT(j)]); sum += c; cnt += (c > 0u) ? 1u : 0u; mine = (j == x) ? c : mine; }
        if (sum == G) break;
        __builtin_amdgcn_s_sleep(1);
        if ((++sp & 255u) == 0u) { if (xb_ld(&bar[XB_TMO])) break; if (sp > XB_SPIN_CAP) { atomicAdd(&bar[XB_TMO], 1u); break; } }
    }
    nloc = mine > 0u ? mine : 1u; nx = cnt > 0u ? cnt : 1u;
}
__device__ __forceinline__ void xcd_barrier(const int g_wid, const XcdBarrier& b) {
    asm volatile("s_waitcnt vmcnt(0)" ::: "memory");
    __syncthreads();
    if (LAUNDER_TID() == 0) {
        unsigned* bar = b.bar;
        __builtin_amdgcn_s_waitcnt(0);
        unsigned nloc = b.st[0], nx = b.st[1];
        if (nloc == 0u) { xcd_barrier_complete(bar, b.x, nloc, nx); b.st[0] = nloc; b.st[1] = nx; }
        const unsigned old = xb_add(&bar[XB_XSUB(b.x)], 1u);
        const unsigned gen = old / nloc;
        if (old + 1u == (gen + 1u) * nloc) {
            __builtin_amdgcn_fence(__ATOMIC_RELEASE, "agent");
            asm volatile("s_waitcnt vmcnt(0)" ::: "memory");
            const unsigned og = xb_add(&bar[XB_TOP], 1u);
            const unsigned tg = og / nx;
            if (og + 1u == (tg + 1u) * nx) xb_add(&bar[XB_TOPGEN], 1u);
            else XB_SPIN(xb_ld(&bar[XB_TOPGEN]) == tg, bar);
            __builtin_amdgcn_fence(__ATOMIC_ACQUIRE, "agent");
            xb_add(&bar[XB_XGEN(b.x)], 1u);
            asm volatile("s_waitcnt vmcnt(0)" ::: "memory");
        } else {
            XB_SPIN(xb_ld(&bar[XB_XGEN(b.x)]) == gen, bar);
            __builtin_amdgcn_fence(__ATOMIC_ACQUIRE, "agent");
            asm volatile("s_waitcnt vmcnt(0)" ::: "memory");
        }
    }
    __syncthreads();
}

namespace pg8 {
constexpr int BM = 256, BK = 64, HALF = 128, HTB = HALF * BK * 2, NXCD = 8, WGM = 8;
__device__ __forceinline__ int lds_byte(int r, int c) { const int st = (r >> 4) * 2 + (c >> 5), rr = r & 15, cc = c & 31, ob = rr * 64 + cc * 2; return st * 1024 + (ob ^ (((ob >> 9) & 1) << 5)); }
__device__ __forceinline__ void stage_rc(int b, int& R, int& C) { const int st = b / 1024, sb = b % 1024, swz = sb ^ (((sb >> 9) & 1) << 5); R = (st >> 1) * 16 + swz / 64; C = (st & 1) * 32 + (swz % 64) / 2; }
__device__ __forceinline__ int perm32(int rho) { const int n = rho >> 4, i = rho & 15; return 8 * (i >> 2) + 4 * n + (i & 3); }
struct Unit { const char* A; const char* B; bf16_t* dst; int nt; int ldo; float scale; int f32; int cch; };
__device__ __forceinline__ bool tile_order(long L, int nM, int nN, int& pm, int& pn) {
    const int nwg = nM * nN; if (L >= nwg) return false;
    int wgid = (int)L; { const int q = nwg / NXCD, r = nwg % NXCD, xcd = wgid % NXCD, off = wgid / NXCD; wgid = (xcd < r ? xcd * (q + 1) : r * (q + 1) + (xcd - r) * q) + off; }
    const int nig = WGM * nN, gid = wgid / nig, fm = gid * WGM, gsz = (nM - fm) < WGM ? (nM - fm) : WGM;
    pm = fm + ((wgid % nig) % gsz); pn = (wgid % nig) / gsz; return true;
}
__device__ __forceinline__ float dpp_ror1(float v) { return __builtin_bit_cast(float, __builtin_amdgcn_mov_dpp(__builtin_bit_cast(int, v), 0x121, 0xf, 0xf, true)); }
__device__ __forceinline__ float dpp_rol1(float v) { return __builtin_bit_cast(float, __builtin_amdgcn_mov_dpp(__builtin_bit_cast(int, v), 0x12F, 0xf, 0xf, true)); }
__device__ __forceinline__ void run_epi_glu(const f32x4 (&acc)[2][2][4][2], const Unit& u, int wr, int wc, int fr, const int fq, const float* cw, const float* cb, LAS float* xb) {
    int cl = wc * 32 + 8 * fq;
    asm volatile("" : "+v"(cl), "+v"(fr));
    const bool ctx = u.f32 == 3;
    if (ctx) {
#pragma unroll
        for (int ai = 0; ai < 2; ++ai) { const int ci = 2 * ai + wr;
            if (fr == 0) { *(LAS f32x4*)(xb + (ci * 2 + 0) * 128 + cl) = acc[ai][0][0][0]; *(LAS f32x4*)(xb + (ci * 2 + 0) * 128 + cl + 4) = acc[ai][0][0][1]; }
            if (fr == 15) { *(LAS f32x4*)(xb + (ci * 2 + 1) * 128 + cl) = acc[ai][0][3][0]; *(LAS f32x4*)(xb + (ci * 2 + 1) * 128 + cl + 4) = acc[ai][0][3][1]; } }
        asm volatile("s_waitcnt lgkmcnt(0)" ::: "memory");
        __builtin_amdgcn_s_barrier();
        asm volatile("" ::: "memory");
    }
    bf16_t* base = u.dst + (size_t)(wr * 64 + fr) * FFN + cl;
#pragma unroll
    for (int h = 0; h < 2; ++h) {
        const int c = u.cch + cl + 4 * h;
        const f32x4 w0 = *(const f32x4*)(cw + c), w1 = *(const f32x4*)(cw + FFN + c), w2 = *(const f32x4*)(cw + 2 * FFN + c), bb = *(const f32x4*)(cb + c);
#pragma unroll
        for (int ai = 0; ai < 2; ++ai) {
            const int ci = 2 * ai + wr;
            f32x4 top = {0.f, 0.f, 0.f, 0.f}, bot = {0.f, 0.f, 0.f, 0.f};
            if (ctx) {
                if (ci > 0) top = *(const LAS f32x4*)(xb + ((ci - 1) * 2 + 1) * 128 + cl + 4 * h);
                if (ci < 3) bot = *(const LAS f32x4*)(xb + ((ci + 1) * 2 + 0) * 128 + cl + 4 * h);
            }
#pragma unroll
            for (int m = 0; m < 4; ++m) {
                float y[4];
#pragma unroll
                for (int x = 0; x < 4; ++x) {
                    const float cur = acc[ai][0][m][h][x];
                    const float upv = (m > 0) ? dpp_ror1(acc[ai][0][m > 0 ? m - 1 : 0][h][x]) : top[x];
                    const float dnv = (m < 3) ? dpp_rol1(acc[ai][0][m < 3 ? m + 1 : 3][h][x]) : bot[x];
                    const float prev = __builtin_bit_cast(float, __builtin_amdgcn_update_dpp(__builtin_bit_cast(int, upv), __builtin_bit_cast(int, cur), 0x111, 0xf, 0xf, false));
                    const float next = __builtin_bit_cast(float, __builtin_amdgcn_update_dpp(__builtin_bit_cast(int, dnv), __builtin_bit_cast(int, cur), 0x101, 0xf, 0xf, false));
                    const float v = prev * w0[x] + cur * w1[x] + next * w2[x] + bb[x];
                    y[x] = v * __builtin_amdgcn_rcpf(1.f + __expf(-v)) * acc[ai][1][m][h][x];
                }
                u32x2 o; o[0] = cvt_pk_bf16(y[0], y[1]); o[1] = cvt_pk_bf16(y[2], y[3]);
                *(u32x2*)(base + (size_t)(ai * HALF + m * 16) * FFN + 4 * h) = o;
            }
        }
    }
    if (ctx) asm volatile("s_waitcnt lgkmcnt(0)" ::: "memory");
}
__device__ __forceinline__ void run_epi(const f32x4 (&acc)[2][2][4][2], const Unit& u, int wr, int wc, int fr, int fq) {
    const float s = u.scale;
    if (u.f32) {
        if (wc == 0) {
#pragma unroll
            for (int ai = 0; ai < 2; ++ai)
#pragma unroll
                for (int m = 0; m < 4; ++m) { float* d = (float*)u.dst + (size_t)(ai * HALF + wr * 64 + m * 16 + fr) * 32 + 8 * fq; *(f32x4*)d = acc[ai][0][m][0]; *(f32x4*)(d + 4) = acc[ai][0][m][1]; }
        }
        return;
    }
    const __amdgpu_buffer_rsrc_t rs = __builtin_amdgcn_make_buffer_rsrc((void*)u.dst, (short)0, 0x7FFFFFF0, 0x00020000);
    const unsigned ldb2 = (unsigned)u.ldo * 2u;
    const unsigned boff = (unsigned)(wr * 64 + fr) * ldb2 + (unsigned)(wc * 32 + 8 * fq) * 2u;
#pragma unroll
    for (int ai = 0; ai < 2; ++ai)
#pragma unroll
        for (int m = 0; m < 4; ++m)
#pragma unroll
            for (int bj = 0; bj < 2; ++bj) { const f32x4 v0 = acc[ai][bj][m][0], v1 = acc[ai][bj][m][1];
                u32x4 o; o[0] = cvt_pk_bf16(v0[0] * s, v0[1] * s); o[1] = cvt_pk_bf16(v0[2] * s, v0[3] * s); o[2] = cvt_pk_bf16(v1[0] * s, v1[1] * s); o[3] = cvt_pk_bf16(v1[2] * s, v1[3] * s);
                __builtin_amdgcn_raw_buffer_store_b128(o, rs, boff + (unsigned)(ai * HALF + m * 16) * ldb2 + (unsigned)(bj * HALF * 2), 0,   16); }
}
template <class Sched>
__device__ __forceinline__ void gemm_phase(const int g_wid, LAS unsigned char* lds, const int lda, const int ldb  , const Sched& S) {
    const int tid = LAUNDER_TID(), wid = __builtin_amdgcn_readfirstlane(tid >> 6), lane = tid & 63, wr = wid >> 2, wc = wid & 3, fr = lane & 15, fq = lane >> 4;
    unsigned voffA[2], voffB[2];
#pragma unroll
    for (int i = 0; i < 2; ++i) { int R, C; stage_rc(tid * 16 + i * 8192, R, C); const int Rb = (R & ~31) + perm32(R & 31);
        voffA[i] = (unsigned)(R * lda + C * 2); voffB[i] = (unsigned)(Rb * ldb + C * 2); }
    const size_t kstep = (size_t)(BK * 2);
    const size_t hstepA = (size_t)HALF * lda, hstepB = (size_t)HALF * ldb;
    const unsigned ldsw = (unsigned)wid * 1024u;
    const int aoff = lds_byte(wr * 64 + fr, fq * 8), boff = lds_byte(wc * 32 + fr, fq * 8);
#define PG8_SA(b, h) (((b) * 2 + (h)) * HTB)
#define PG8_SB(b, h) ((4 + (b) * 2 + (h)) * HTB)
#define PG8_STAGE(bufoff, gbase, voff) do { _Pragma("unroll") for (int _i = 0; _i < 2; ++_i) \
        __builtin_amdgcn_global_load_lds((const unsigned*)((const char*)(gbase) + (voff)[_i]), (LAS unsigned*)(lds + (bufoff) + ldsw + _i * 8192), 16, 0, 0); } while (0)
#define PG8_LDA(dst, b, h) do { _Pragma("unroll") for (int m = 0; m < 4; ++m) _Pragma("unroll") for (int k = 0; k < 2; ++k) dst[m][k] = *(const LAS bf16x8*)(lds + PG8_SA(b, h) + aoff + m * 2048 + k * 1024); } while (0)
#define PG8_LDB(dst, b, h) do { _Pragma("unroll") for (int n = 0; n < 2; ++n) _Pragma("unroll") for (int k = 0; k < 2; ++k) dst[n][k] = *(const LAS bf16x8*)(lds + PG8_SB(b, h) + boff + n * 2048 + k * 1024); } while (0)
#define PG8_MMA(ai, bj, At, Bt) do { __builtin_amdgcn_s_setprio(1); _Pragma("unroll") for (int m = 0; m < 4; ++m) _Pragma("unroll") for (int n = 0; n < 2; ++n) _Pragma("unroll") for (int k = 0; k < 2; ++k) \
        acc[ai][bj][m][n] = __builtin_amdgcn_mfma_f32_16x16x32_bf16(Bt[n][k], At[m][k], acc[ai][bj][m][n], 0, 0, 0); __builtin_amdgcn_s_setprio(0); } while (0)
#define PG8_WAIT_V(n) asm volatile("s_waitcnt vmcnt(" #n ")" ::: "memory")
#define PG8_WAIT_L(n) asm volatile("s_waitcnt lgkmcnt(" #n ")" ::: "memory")
#define PG8_BAR __builtin_amdgcn_s_barrier()
#define PG8_SCHED __builtin_amdgcn_sched_barrier(0)
    Unit cur, nxt; int ui = 0;
    if (!S.next(0, cur)) return;
    f32x4 acc[2][2][4][2];
#pragma unroll
    for (int a = 0; a < 2; ++a)
#pragma unroll
        for (int b = 0; b < 2; ++b)
#pragma unroll
            for (int m = 0; m < 4; ++m)
#pragma unroll
                for (int n = 0; n < 2; ++n) acc[a][b][m][n] = (f32x4){0.f, 0.f, 0.f, 0.f};
    bf16x8 At[4][2], B0[2][2], B1[2][2];
    const char* cA = cur.A; const char* cB = cur.B;
    PG8_STAGE(PG8_SB(0, 0), cB, voffB); PG8_STAGE(PG8_SA(0, 0), cA, voffA); PG8_STAGE(PG8_SB(0, 1), cB + hstepB, voffB); PG8_STAGE(PG8_SA(0, 1), cA + hstepA, voffA);
    if (wr == 1) PG8_BAR;
    PG8_WAIT_V(4); PG8_BAR;
    PG8_STAGE(PG8_SB(1, 0), cB + kstep, voffB); PG8_STAGE(PG8_SA(1, 0), cA + kstep, voffA); PG8_STAGE(PG8_SB(1, 1), cB + hstepB + kstep, voffB);
    PG8_WAIT_V(6); PG8_BAR;
    for (;;) {
        const bool has_next = S.next(ui + 1, nxt);
        const char* nA = has_next ? nxt.A : cA; const char* nB = has_next ? nxt.B : cB;
        const int nt = cur.nt;
        for (int t = 0; t < nt; t += 2) {
            const bool last = (t == nt - 2);
            const char* a1 = cA + (size_t)(t + 1) * kstep;
            const char* a2 = last ? nA : cA + (size_t)(t + 2) * kstep; const char* b2 = last ? nB : cB + (size_t)(t + 2) * kstep;
            const char* a3 = a2 + kstep; const char* b3 = b2 + kstep;
            PG8_LDB(B0, 0, 0); PG8_SCHED; PG8_LDA(At, 0, 0); PG8_STAGE(PG8_SA(1, 1), a1 + hstepA, voffA);
            PG8_WAIT_L(8); PG8_BAR; PG8_WAIT_L(0); PG8_MMA(0, 0, At, B0); PG8_BAR; PG8_SCHED;
            PG8_LDB(B1, 0, 1); PG8_STAGE(PG8_SB(0, 0), b2, voffB);
            PG8_BAR; PG8_WAIT_L(0); PG8_MMA(0, 1, At, B1); PG8_BAR;
            PG8_LDA(At, 0, 1); PG8_STAGE(PG8_SA(0, 0), a2, voffA);
            PG8_BAR; PG8_WAIT_L(0); PG8_MMA(1, 0, At, B0); PG8_BAR; PG8_SCHED;
            PG8_STAGE(PG8_SB(0, 1), b2 + hstepB, voffB);
            PG8_WAIT_V(6); PG8_BAR; PG8_MMA(1, 1, At, B1); PG8_BAR;
            PG8_LDB(B0, 1, 0); PG8_SCHED; PG8_LDA(At, 1, 0); PG8_STAGE(PG8_SA(0, 1), a2 + hstepA, voffA);
            PG8_WAIT_L(8); PG8_BAR; PG8_WAIT_L(0); PG8_MMA(0, 0, At, B0); PG8_BAR; PG8_SCHED;
            PG8_LDB(B1, 1, 1); PG8_STAGE(PG8_SB(1, 0), b3, voffB);
            PG8_BAR; PG8_WAIT_L(0); PG8_MMA(0, 1, At, B1); PG8_BAR;
            PG8_LDA(At, 1, 1); PG8_STAGE(PG8_SA(1, 0), a3, voffA);
            PG8_BAR; PG8_WAIT_L(0); PG8_MMA(1, 0, At, B0); PG8_BAR; PG8_SCHED;
            PG8_STAGE(PG8_SB(1, 1), b3 + hstepB, voffB);
            PG8_WAIT_V(6); PG8_BAR; PG8_MMA(1, 1, At, B1); PG8_BAR;
        }
        if (wr == 0) PG8_BAR;
        if (cur.f32 >= 2) run_epi_glu(acc, cur, wr, wc, fr, fq, S.cw, S.cb, (LAS float*)(lds + LDS_XB)); else run_epi(acc, cur, wr, wc, fr, fq);
        if (!has_next) break;
        if (wr == 1) PG8_BAR;
#pragma unroll
        for (int a = 0; a < 2; ++a)
#pragma unroll
            for (int b = 0; b < 2; ++b)
#pragma unroll
                for (int m = 0; m < 4; ++m)
#pragma unroll
                    for (int n = 0; n < 2; ++n) acc[a][b][m][n] = (f32x4){0.f, 0.f, 0.f, 0.f};
        cur = nxt; cA = nA; cB = nB; ++ui;
    }
    PG8_WAIT_V(0);
    PG8_BAR;
#undef PG8_SA
#undef PG8_SB
#undef PG8_STAGE
#undef PG8_LDA
#undef PG8_LDB
#undef PG8_MMA
#undef PG8_WAIT_V
#undef PG8_WAIT_L
#undef PG8_BAR
#undef PG8_SCHED
}
}
using pg8::Unit;

struct GSched { int kind; const char* A; const char* B; const char* A2; const char* B2; bf16_t* o0; bf16_t* o1; const float* cw; const float* cb; int lda, ldb, nM, nN, nt, koff, G, c;
    __device__ __forceinline__ bool next(int i, Unit& u) const {
        u.scale = 1.f; u.f32 = 0; u.nt = nt; u.cch = 0;
        if (kind <= 2) { int pm, pn; if (!pg8::tile_order((long)i * G + c, nM, nN, pm, pn)) return false;
            u.A = A + (size_t)pm * 256 * lda; u.B = B + (size_t)pn * 256 * ldb;
            if (kind == 0) {
                if (pn < 2) { u.dst = (bf16_t*)((char*)o0 + S_Q) + (size_t)pm * 256 * 512 + pn * 256; u.ldo = 512; u.scale = 0.08838834764831845f; }
                else if (pn < 4) { u.dst = (bf16_t*)((char*)o0 + S_K) + (size_t)pm * 256 * 512 + (pn - 2) * 256; u.ldo = 512; }
                else if (pn < 8) { u.dst = (bf16_t*)((char*)o0 + S_V) + (size_t)pm * 256 * 1024 + (pn - 4) * 256; u.ldo = 1024; }
                else if (pn < 12) { u.dst = (bf16_t*)((char*)o0 + S_R) + (size_t)pm * 256 * 1024 + (pn - 8) * 256; u.ldo = 1024; }
                else { u.dst = (bf16_t*)((float*)((char*)o0 + S_GLR) + (size_t)pm * 256 * 32); u.ldo = 0; u.f32 = 1; } }
            else if (kind == 1) { u.ldo = FFN; u.dst = o0 + (size_t)pm * 256 * FFN + pn * 128; u.cch = pn * 128; u.f32 = pm < 16 ? 3 : 2; }
            else { const int cs = pm >> 2, n0 = (pm & 3) * 256; u.ldo = 8192;
                if (pn < 16) u.dst = o0 + (size_t)n0 * 8192 + pn * 512 + cs * 256;
                else { const int t0 = (pn - 16) * 256, b = t0 >> 11, l0 = t0 & 2047; u.dst = o1 + (size_t)n0 * 8192 + b * 4096 + cs * 2048 + l0; } }
            return true; }
        if (kind == 3) { int pm, p8; if (!pg8::tile_order((long)i * G + c, 32, 8, pm, p8)) return false; const int pn = p8 & 3, ks = p8 >> 2;
            u.A = A + (size_t)pm * 256 * lda + (size_t)ks * koff; u.B = B + (size_t)pn * 256 * ldb + (size_t)ks * koff;
            u.dst = o0 + (size_t)ks * PART_STRIDE + (size_t)pm * 256 * D + pn * 256; u.ldo = D; return true; }
        if (kind == 4) { const int id = i * G + c; if (id >= 64) return false; const int pm = id & 3, g = (id >> 2) & 3, cs = (id >> 4) & 1, layer = id >> 5;
            u.A = A + (size_t)layer * 2 * MB + (size_t)pm * 256 * 2048 + g * 512; u.B = B + (size_t)cs * 256 * 512;
            u.dst = o0 + (size_t)(id >> 4) * 1048576 + (size_t)pm * 256 * 1024 + g * 256; u.ldo = 1024; return true; }
        if (kind == 5) { const int id = i * G + c; if (id >= 64) return false; const int pn = id & 3, pm = (id >> 2) & 3, lc = id >> 4, layer = lc >> 1, cs = lc & 1;
            u.A = A + (size_t)layer * 2 * MB + (size_t)pm * 256 * 2048; u.B = B + (size_t)lc * 2 * MB + (size_t)pn * 256 * 2048;
            u.dst = o0 + (size_t)layer * 2097152 + (size_t)(cs * 1024 + pm * 256) * 1024 + pn * 256; u.ldo = 1024; return true; }
        {
            u.ldo = D;
            if (G != 256) {
                const int L = i * G + c; if (L >= 384) return false;
                if (L < 256) { const int ks = L & 3, pn = (L >> 2) & 3, pm = (L >> 4) & 7, b = L >> 7;
                    u.A = A + (size_t)pm * 256 * 8192 + ks * 2048; u.B = B + (size_t)pn * 256 * 16384 + (size_t)b * 8192 + ks * 2048; u.nt = 16;
                    u.dst = o0 + (size_t)ks * PART_STRIDE + (size_t)(NCTX + b * 2048 + pm * 256) * D + pn * 256; u.scale = 0.0013810679320049757f; return true; }
                const int id = L - 256, ks = id & 1, pn = (id >> 1) & 3, b = id >> 3;
                u.A = A2 + ks * 512; u.B = B2 + (size_t)pn * 256 * 16384 + (size_t)b * 1024 + ks * 512; u.nt = 4;
                u.dst = o0 + (size_t)ks * PART_STRIDE + (size_t)b * 256 * D + pn * 256; u.scale = 0.00390625f; return true; }
            if (i == 0) { const int id = c; if (id >= 256) return false; const int ks = id & 3, pn = (id >> 2) & 3, pm = (id >> 4) & 7, b = id >> 7;
                u.A = A + (size_t)pm * 256 * 8192 + ks * 2048; u.B = B + (size_t)pn * 256 * 16384 + (size_t)b * 8192 + ks * 2048; u.nt = 16;
                u.dst = o0 + (size_t)ks * PART_STRIDE + (size_t)(NCTX + b * 2048 + pm * 256) * D + pn * 256; u.scale = 0.0013810679320049757f; return true; }
            if (i == 1) { const int id = G - 1 - c; if (id >= 128) return false; const int ks = id & 1, pn = (id >> 1) & 3, b = id >> 3;
                u.A = A2 + ks * 512; u.B = B2 + (size_t)pn * 256 * 16384 + (size_t)b * 1024 + ks * 512; u.nt = 4;
                u.dst = o0 + (size_t)ks * PART_STRIDE + (size_t)b * 256 * D + pn * 256; u.scale = 0.00390625f; return true; }
            return false; }
    } };

__device__ void setup_phase(const int g_wid, const Params& p, LAS unsigned char* ldsb) {
    const int tid_l = LAUNDER_TID(), blk_l = LAUNDER_BLK(); unsigned char* const ws_l = LAUNDER_PTR(p.ws); (void)tid_l; (void)blk_l; (void)ws_l;
    LAS float* lf = (LAS float*)ldsb;
    const int tid = tid_l, blk = blk_l, G = gridDim.x;
    unsigned char* ws = ws_l;
    for (int job = blk; job < 256; job += G) {
        const int layer = job >> 6, col0 = (job & 63) * 96;
        for (int i = tid; i < 3072; i += NT) { const int v = i >> 10, k = i & 1023; const float x = (v == 0) ? p.c_ctx[k] : p.c[(v - 1) * 1024 + k]; lf[i] = silu_f(x); }
        __syncthreads();
        if (tid < 384) {
            const int cq = tid % 24, rg = tid / 24;
            f32x4 a0 = {0.f, 0.f, 0.f, 0.f}, a1 = a0, a2 = a0;
            const float* wp = p.w_mod + ((size_t)layer * 1024 + rg * 64) * 6144 + col0 + cq * 4;
#pragma unroll 32
            for (int k = 0; k < 64; ++k) { const f32x4 w = *(const f32x4*)(wp + (size_t)k * 6144); const int kk = rg * 64 + k;
                a0 += w * lf[kk]; a1 += w * lf[1024 + kk]; a2 += w * lf[2048 + kk]; }
            LAS float* red = lf + 3072;
#pragma unroll
            for (int e = 0; e < 4; ++e) { red[(rg * 3 + 0) * 96 + cq * 4 + e] = a0[e]; red[(rg * 3 + 1) * 96 + cq * 4 + e] = a1[e]; red[(rg * 3 + 2) * 96 + cq * 4 + e] = a2[e]; }
        }
        __syncthreads();
        if (tid < 288) { const int v = tid / 96, cc = tid % 96; float s = p.b_mod[layer * 6144 + col0 + cc];
            for (int rg = 0; rg < 16; ++rg) s += lf[3072 + (rg * 3 + v) * 96 + cc];
            ((float*)(ws + WS_MODV))[(layer * 3 + v) * 6144 + col0 + cc] = s; }
        __syncthreads();
    }
    {
        constexpr int T_GIN = 2 * 16 * 13, T_GO = 2 * 16 * 4, T_FO = 2 * 16 * 4, T_UP = 4 * 16 * 22, T_DN = 4 * 44 * 4, T_ALL = T_GIN + T_GO + T_FO + T_UP + T_DN;
        for (int job = blk; job < T_ALL; job += G) {
            const float* src; bf16_t* dst; int K, N, kt, ntile; int j = job; bool up = false;
            if (j < T_GIN) { const int l = j / (16 * 13); j %= 16 * 13; kt = j / 13; ntile = j % 13; K = 1024; N = GIN; src = p.gla_w_in + (size_t)l * 1024 * GIN; dst = (bf16_t*)(ws + WS_WGIN) + (size_t)l * GINP * 1024; }
            else if ((j -= T_GIN) < T_GO) { const int l = j / 64; j %= 64; kt = j / 4; ntile = j % 4; K = 1024; N = 1024; src = p.gla_w_o + (size_t)l * 1048576; dst = (bf16_t*)(ws + WS_WGO) + (size_t)l * 1048576; }
            else if ((j -= T_GO) < T_FO) { const int l = j / 64; j %= 64; kt = j / 4; ntile = j % 4; K = 1024; N = 1024; src = p.fnet_w_o + (size_t)l * 1048576; dst = (bf16_t*)(ws + WS_WOT) + (size_t)l * 1048576; }
            else if ((j -= T_FO) < T_UP) { const int l = j / (16 * 22); j %= 16 * 22; kt = j / 22; ntile = j % 22; up = true; K = 1024; N = 2 * FFN; src = p.ffn_w_up + (size_t)l * 1024 * 2 * FFN; dst = (bf16_t*)(ws + WS_WUP) + (size_t)l * 2 * FFN * 1024; }
            else { j -= T_UP; const int l = j / (44 * 4); j %= 44 * 4; kt = j / 4; ntile = j % 4; K = FFN; N = 1024; src = p.ffn_w_down + (size_t)l * FFN * 1024; dst = (bf16_t*)(ws + WS_WDN) + (size_t)l * 1024 * FFN; }
            const int k0 = kt * 64, n0 = ntile * 256;
            f32x4 wv[8];
#pragma unroll
            for (int u = 0; u < 8; ++u) { const int kr = (tid >> 6) + 8 * u, n = n0 + (tid & 63) * 4; wv[u] = (f32x4){0.f, 0.f, 0.f, 0.f}; if (n < N) wv[u] = *(const f32x4*)(src + (size_t)(k0 + kr) * N + n); }
#pragma unroll
            for (int u = 0; u < 8; ++u) { const int kr = (tid >> 6) + 8 * u;
#pragma unroll
                for (int e = 0; e < 4; ++e) lf[kr * 257 + (tid & 63) * 4 + e] = wv[u][e]; }
            __syncthreads();
            { const int n = tid >> 1, kh = tid & 1; int orow = n0 + n;
              if (up) { const int part = n0 >= FFN ? 1 : 0, ch = n0 + n - part * FFN; orow = (ch >> 7) * 256 + part * 128 + (ch & 127); }
#pragma unroll
              for (int c4 = 0; c4 < 4; ++c4) { u32x4 o;
#pragma unroll
                  for (int e = 0; e < 4; ++e) o[e] = cvt_pk_bf16(lf[(kh * 32 + c4 * 8 + 2 * e) * 257 + n], lf[(kh * 32 + c4 * 8 + 2 * e + 1) * 257 + n]);
                  *(u32x4*)(dst + (size_t)orow * K + k0 + kh * 32 + c4 * 8) = o; } }
            __syncthreads();
        }
    }
    const size_t gt = (size_t)blk * NT + tid, gs = (size_t)G * NT;
    for (size_t i = gt; i < 2 * 1048576 / 4; i += gs) { const f32x4 w = *(const f32x4*)(p.fnet_w_in + i * 4); u32x2 o; o[0] = cvt_pk_bf16(w[0], w[1]); o[1] = cvt_pk_bf16(w[2], w[3]); *(u32x2*)((bf16_t*)(ws + WS_WINB) + i * 4) = o; }
    LAS float* tc = lf; LAS float* ts = lf + 2048;
    __syncthreads();
    for (int i = tid; i < 2048; i += NT) { float s_, c_; sincospif((float)i * (1.f / 1024.f), &s_, &c_); tc[i] = c_; ts[i] = s_; }
    __syncthreads();
    for (size_t i = gt; i < 2 * 65536; i += gs) { const int cs = (int)(i >> 16), a = (int)(i >> 8) & 255, b = (int)i & 255; const int r = ((a * b) & 255) * 8;
        ((bf16_t*)(ws + WS_CW))[i] = f2bf(cs ? ts[r] : tc[r]); }
    for (size_t i = gt; i < 256 * 512; i += gs) { const int lp = (int)(i >> 9), k = (int)i & 511, cs = k >> 8, l = k & 255; const int r = ((lp * l) & 255) * 8;
        ((bf16_t*)(ws + WS_DL256))[(size_t)lp * 4096 + k] = f2bf(cs ? -ts[r] : tc[r]); }
    for (size_t i = gt; i < (size_t)2048 * 4096 / 2; i += gs) { const int lp = (int)(i >> 11), k = ((int)i & 2047) * 2, cs = k >> 11, l = k & 2047; const int r0 = (lp * l) & 2047, r1 = (lp * (l + 1)) & 2047;
        ((unsigned*)(ws + WS_DL2048))[i] = cs ? cvt_pk_bf16(-ts[r0], -ts[r1]) : cvt_pk_bf16(tc[r0], tc[r1]); }
}

template <bool FINAL>
__device__ void norm_phase(const int g_wid, const Params& p, const float* src_ctx, const float* src_lat, const float* gate  , int np_ctx, int np_lat,
                           const float* g, const float* shp, const float* scp) {
    const int tid_l = LAUNDER_TID(), blk_l = LAUNDER_BLK(); unsigned char* const ws_l = LAUNDER_PTR(p.ws); (void)tid_l; (void)blk_l; (void)ws_l;
    const int lane = tid_l & 63, gw = (blk_l * NT + tid_l) >> 6, nw = (gridDim.x * NT) >> 6;
    float* X = (float*)(ws_l + WS_X); bf16_t* H = (bf16_t*)(ws_l + WS_H); const bf16_t* part = (const bf16_t*)(ws_l + WS_S + S_PART);
    for (int t0 = gw; t0 < NTOK / 2; t0 += nw) {
        f32x4 x[2][4]; u32x2 w[2][4][4]; f32x4 gtv[2][4]; int vecs[2];
#pragma unroll
        for (int q = 0; q < 2; ++q) {
            const int tok = t0 + q * (NTOK / 2);
            vecs[q] = tok < NCTX ? 0 : 1 + ((tok - NCTX) >> 11);
            const float* src = src_ctx ? (tok < NCTX ? src_ctx + (size_t)tok * D : src_lat + (size_t)(tok - NCTX) * D) : X + (size_t)tok * D;
            const int np = tok < NCTX ? np_ctx : np_lat;
#pragma unroll
            for (int u = 0; u < 4; ++u) { const int col = u * 256 + lane * 4; x[q][u] = *(const f32x4*)(src + col);
#pragma unroll
                for (int s = 0; s < 4; ++s) { w[q][u][s] = (u32x2){0u, 0u}; if (s < np) w[q][u][s] = *(const u32x2*)(part + (size_t)s * PART_STRIDE + (size_t)tok * D + col); }
                gtv[q][u] = (f32x4){0.f, 0.f, 0.f, 0.f}; if (np > 0) gtv[q][u] = *(const f32x4*)(gate + vecs[q] * 6144 + col); }
        }
#pragma unroll
        for (int q = 0; q < 2; ++q) {
            const int tok = t0 + q * (NTOK / 2), vec = vecs[q];
            float ss = 0.f;
#pragma unroll
            for (int u = 0; u < 4; ++u) { f32x4 a = {0.f, 0.f, 0.f, 0.f};
#pragma unroll
                for (int s = 0; s < 4; ++s) { a[0] += bf_lo(w[q][u][s][0]); a[1] += bf_hi(w[q][u][s][0]); a[2] += bf_lo(w[q][u][s][1]); a[3] += bf_hi(w[q][u][s][1]); }
                x[q][u] += gtv[q][u] * a;
                ss += x[q][u][0] * x[q][u][0] + x[q][u][1] * x[q][u][1] + x[q][u][2] * x[q][u][2] + x[q][u][3] * x[q][u][3]; }
#pragma unroll
            for (int o = 32; o > 0; o >>= 1) ss += __shfl_xor(ss, o);
            const float rstd = rsqrtf(ss * (1.f / 1024.f) + 1e-6f);
#pragma unroll
            for (int u = 0; u < 4; ++u) { const int col = u * 256 + lane * 4; const f32x4 gg = *(const f32x4*)(g + col);
                if (FINAL) { *(f32x4*)(p.out + (size_t)tok * D + col) = x[q][u] * rstd * gg; }
                else { if (np_ctx + np_lat > 0) *(f32x4*)(X + (size_t)tok * D + col) = x[q][u];
                    const f32x4 sh = *(const f32x4*)(shp + vec * 6144 + col), sc = *(const f32x4*)(scp + vec * 6144 + col);
                    const f32x4 h = x[q][u] * rstd * gg * (sc + 1.f) + sh; u32x2 o; o[0] = cvt_pk_bf16(h[0], h[1]); o[1] = cvt_pk_bf16(h[2], h[3]); *(u32x2*)(H + (size_t)tok * D + col) = o; } }
        }
    }
}

__device__ void gate_phase(const int g_wid, const Params& p, LAS unsigned char* ldsb, int j) {
    const int tid_l = LAUNDER_TID(), blk_l = LAUNDER_BLK(); unsigned char* const ws_l = LAUNDER_PTR(p.ws); (void)tid_l; (void)blk_l; (void)ws_l;
    LAS float* lg = (LAS float*)ldsb;
    LAS unsigned char* lt = ldsb + 8192;
    const int tid = tid_l; unsigned char* S = ws_l + WS_S;
    const bf16_t* Q = (const bf16_t*)(S + S_Q); const bf16_t* K = (const bf16_t*)(S + S_K); const bf16_t* V = (const bf16_t*)(S + S_V); const float* GLR = (const float*)(S + S_GLR);
    for (int unit = blk_l; unit < 256; unit += gridDim.x) {
        const int chunk = unit >> 1, half = unit & 1, tok0 = chunk * 64;
        for (int i = tid; i < 2048; i += NT) lg[i] = GLR[(size_t)tok0 * 32 + i];
        u32x4 vld[8];
#pragma unroll
        for (int tl = 0; tl < 8; ++tl) vld[tl] = *(const u32x4*)(V + (size_t)(tok0 + (tid >> 3)) * 1024 + half * 512 + tl * 64 + (tid & 7) * 8);
        __syncthreads();
        const int dir = __builtin_amdgcn_readfirstlane(tid >> 8), ch = half * 256 + (tid & 255);
        f32x4 w4[4];
#pragma unroll
        for (int r = 0; r < 16; ++r) w4[r >> 2][r & 3] = p.gla_w_g2[(((size_t)j * 2 + dir) * 16 + r) * 512 + ch];
        const float bg = p.gla_b_g[(j * 2 + dir) * 512 + ch];
        bf16_t* Qo = (bf16_t*)(S + (dir ? S_QB : S_QF)); bf16_t* Ko = (bf16_t*)(S + (dir ? S_KB : S_KF)); bf16_t* KTo = (bf16_t*)(S + (dir ? S_KBT : S_KFT));
        float bc = 0.f;
        unsigned short qc[8], kc[8], qn[8], kn[8];
#pragma unroll
        for (int e = 0; e < 8; ++e) { const int tt = dir ? (63 - e) : e; const size_t gi = (size_t)(tok0 + tt) * 512 + ch; qc[e] = Q[gi]; kc[e] = K[gi]; }
#pragma unroll 2
        for (int g8 = 0; g8 < 8; ++g8) {
            if (g8 < 7) {
#pragma unroll
                for (int e = 0; e < 8; ++e) { const int tt = dir ? (63 - ((g8 + 1) * 8 + e)) : ((g8 + 1) * 8 + e); const size_t gi = (size_t)(tok0 + tt) * 512 + ch; qn[e] = Q[gi]; kn[e] = K[gi]; }
            }
            float kt[8];
#pragma unroll
            for (int e = 0; e < 8; ++e) {
                const int tt = dir ? (63 - (g8 * 8 + e)) : (g8 * 8 + e);
                f32x4 lv = *(const LAS f32x4*)(lg + tt * 32 + dir * 16) * w4[0];
#pragma unroll
                for (int r4 = 1; r4 < 4; ++r4) lv += *(const LAS f32x4*)(lg + tt * 32 + dir * 16 + r4 * 4) * w4[r4];
                const float lo = bg + ((lv[0] + lv[1]) + (lv[2] + lv[3]));
                const float ls = fminf(lo, 0.f) - __logf(1.f + __expf(-fabsf(lo)));
                bc += ls * 0.0625f;
                const size_t gi = (size_t)(tok0 + tt) * 512 + ch;
                const float eb = __expf(bc);
                const float qv = bf2f(qc[e]) * eb, kv = bf2f(kc[e]) * __builtin_amdgcn_rcpf(eb);
                Qo[gi] = f2bf(qv); Ko[gi] = f2bf(kv); kt[e] = kv;
            }
            const int t8 = dir ? (7 - g8) : g8;
            u32x4 o;
            if (dir) { o[0] = cvt_pk_bf16(kt[7], kt[6]); o[1] = cvt_pk_bf16(kt[5], kt[4]); o[2] = cvt_pk_bf16(kt[3], kt[2]); o[3] = cvt_pk_bf16(kt[1], kt[0]); }
            else { o[0] = cvt_pk_bf16(kt[0], kt[1]); o[1] = cvt_pk_bf16(kt[2], kt[3]); o[2] = cvt_pk_bf16(kt[4], kt[5]); o[3] = cvt_pk_bf16(kt[6], kt[7]); }
            *(u32x4*)(KTo + ((size_t)chunk * 512 + ch) * 64 + t8 * 8) = o;
#pragma unroll
            for (int e = 0; e < 8; ++e) { qc[e] = qn[e]; kc[e] = kn[e]; }
        }
        ((float*)(S + S_EE))[((size_t)dir * 128 + chunk) * 512 + ch] = __expf(bc);
        { bf16_t* VT = (bf16_t*)(S + S_VT);
#pragma unroll
          for (int tl = 0; tl < 8; ++tl) {
              __syncthreads();
              { LAS unsigned* d = (LAS unsigned*)(lt + (tid >> 3) * 132 + (tid & 7) * 16); d[0] = vld[tl][0]; d[1] = vld[tl][1]; d[2] = vld[tl][2]; d[3] = vld[tl][3]; }
              __syncthreads();
              const int dv = tid >> 3, t8 = tid & 7; unsigned short vv[8];
#pragma unroll
              for (int e = 0; e < 8; ++e) vv[e] = *(const LAS unsigned short*)(lt + (t8 * 8 + e) * 132 + dv * 2);
              u32x4 o; o[0] = vv[0] | ((unsigned)vv[1] << 16); o[1] = vv[2] | ((unsigned)vv[3] << 16); o[2] = vv[4] | ((unsigned)vv[5] << 16); o[3] = vv[6] | ((unsigned)vv[7] << 16);
              *(u32x4*)(VT + ((size_t)chunk * 1024 + half * 512 + tl * 64 + dv) * 64 + t8 * 8) = o; } }
        __syncthreads();
    }
}

template <int NDT>
__device__ __forceinline__ void scan_unit(const Params& p, LAS unsigned char* lds, unsigned char* S, const int j, const bool lat, const int b, const int h, const int dir, const int slice,
                                          const int tid, const int w, const int r, const int q) {
    constexpr int LQ = 0, LK = 17408, LKT = 34816, LVT = 53248, OPB = 62464, LST = 2 * OPB, LAT = LST + 17408, LE = LAT + 9216;
    static_assert(LE + 1024 <= LDS_TOP, "scan LDS image");
    constexpr int DVS = 16 * NDT, TPW = NDT / 2;
    const int nc = lat ? 32 : 4, tokbase = lat ? NCTX + b * 2048 : b * 256, chunk0 = tokbase >> 6;
    const bf16_t* Qs = (const bf16_t*)(S + (dir ? S_QB : S_QF)); const bf16_t* Ks = (const bf16_t*)(S + (dir ? S_KB : S_KF));
    const bf16_t* KTs = (const bf16_t*)(S + (dir ? S_KBT : S_KFT)); const bf16_t* VTs = (const bf16_t*)(S + S_VT);
    const float* Es = (const float*)(S + S_EE) + (size_t)dir * 128 * 512;
    bf16_t* O = (bf16_t*)(S + (dir ? S_OB : S_OF));
    f32x4 acc[NDT];
#pragma unroll
    for (int nd = 0; nd < NDT; ++nd) {
#pragma unroll
        for (int jj = 0; jj < 4; ++jj) { const int kk = w * 16 + q * 4 + jj, dv = nd * 16 + r;
            acc[nd][jj] = lat ? p.state_gla[((((size_t)(b * 2 + j) * 2 + dir) * 4 + h) * 128 + kk) * 256 + slice * DVS + dv] : 0.f; }
        u32x2 o; o[0] = cvt_pk_bf16(acc[nd][0], acc[nd][1]); o[1] = cvt_pk_bf16(acc[nd][2], acc[nd][3]);
        *(LAS u32x2*)(lds + LST + (nd * 16 + r) * 272 + (w * 16 + q * 4) * 2) = o;
    }
    u32x4 pq[2], pk[2], pkt[2], pvt = {0u, 0u, 0u, 0u}; float pe = 0.f;
#define SCAN_LOAD(s_) do { const int cgl_ = chunk0 + (dir ? nc - 1 - (s_) : (s_)); const size_t t0_ = (size_t)cgl_ * 64; \
    _Pragma("unroll") for (int u = 0; u < 2; ++u) { const int i = (tid >> 4) + 32 * u, pc = tid & 15; \
        pq[u] = *(const u32x4*)(Qs + (t0_ + i) * 512 + h * 128 + pc * 8); pk[u] = *(const u32x4*)(Ks + (t0_ + i) * 512 + h * 128 + pc * 8); \
        pkt[u] = *(const u32x4*)(KTs + ((size_t)cgl_ * 512 + h * 128) * 64 + (size_t)(tid + 512 * u) * 8); } \
    if (tid < DVS * 8) pvt = *(const u32x4*)(VTs + ((size_t)cgl_ * 1024 + h * 256 + slice * DVS) * 64 + (size_t)tid * 8); \
    if (tid < 128) pe = Es[(size_t)cgl_ * 512 + h * 128 + tid]; } while (0)
#define SCAN_WRITE(ob_) do { LAS unsigned char* const lb_ = lds + (ob_) * OPB; \
    _Pragma("unroll") for (int u = 0; u < 2; ++u) { const int i = (tid >> 4) + 32 * u, pc = tid & 15; \
        *(LAS u32x4*)(lb_ + LQ + i * 272 + pc * 16) = pq[u]; *(LAS u32x4*)(lb_ + LK + i * 272 + pc * 16) = pk[u]; \
        const int id2 = tid + 512 * u; *(LAS u32x4*)(lb_ + LKT + (id2 >> 3) * 144 + (id2 & 7) * 16) = pkt[u]; } \
    if (tid < DVS * 8) *(LAS u32x4*)(lb_ + LVT + (tid >> 3) * 144 + (tid & 7) * 16) = pvt; \
    if (tid < 128) *(LAS float*)(lds + LE + (ob_) * 512 + tid * 4) = pe; } while (0)
    SCAN_LOAD(0);
    SCAN_WRITE(0);
    __syncthreads();
    for (int s = 0; s < nc; ++s) {
        const int cur = s & 1; LAS unsigned char* const lb = lds + cur * OPB;
        const int cgl = chunk0 + (dir ? nc - 1 - s : s); const size_t tok0 = (size_t)cgl * 64;
        if (s + 1 < nc) SCAN_LOAD(s + 1);
        const int mi = w >> 1, n0 = 2 * (w & 1), d0 = TPW * (w & 1);
        const f32x4 e4 = *(const LAS f32x4*)(lds + LE + cur * 512 + (w * 16 + q * 4) * 4);
        bf16x8 qa[4];
        {
            bf16x8 kb[2][4], ka[2], vb[NDT][2];
#pragma unroll
            for (int ks = 0; ks < 4; ++ks) { qa[ks] = *(const LAS bf16x8*)(lb + LQ + (mi * 16 + r) * 272 + (ks * 32 + q * 8) * 2);
#pragma unroll
                for (int t = 0; t < 2; ++t) kb[t][ks] = *(const LAS bf16x8*)(lb + LK + ((n0 + t) * 16 + r) * 272 + (ks * 32 + q * 8) * 2); }
#pragma unroll
            for (int ks = 0; ks < 2; ++ks) { ka[ks] = *(const LAS bf16x8*)(lb + LKT + (w * 16 + r) * 144 + (ks * 32 + q * 8) * 2);
#pragma unroll
                for (int nd = 0; nd < NDT; ++nd) vb[nd][ks] = *(const LAS bf16x8*)(lb + LVT + (nd * 16 + r) * 144 + (ks * 32 + q * 8) * 2); }
            f32x4 at[2] = {{0.f, 0.f, 0.f, 0.f}, {0.f, 0.f, 0.f, 0.f}};
#pragma unroll
            for (int ks = 0; ks < 4; ++ks)
#pragma unroll
                for (int t = 0; t < 2; ++t) at[t] = __builtin_amdgcn_mfma_f32_16x16x32_bf16(kb[t][ks], qa[ks], at[t], 0, 0, 0);
#pragma unroll
            for (int ks = 0; ks < 2; ++ks)
#pragma unroll
                for (int nd = 0; nd < NDT; ++nd) acc[nd] = __builtin_amdgcn_mfma_f32_16x16x32_bf16(ka[ks], vb[nd][ks], acc[nd], 0, 0, 0);
#pragma unroll
            for (int t = 0; t < 2; ++t) { const int i = mi * 16 + r, j0 = (n0 + t) * 16 + q * 4; float v[4];
#pragma unroll
                for (int jj = 0; jj < 4; ++jj) { const bool keep = dir ? (j0 + jj >= i) : (j0 + jj <= i); v[jj] = keep ? at[t][jj] : 0.f; }
                u32x2 o; o[0] = cvt_pk_bf16(v[0], v[1]); o[1] = cvt_pk_bf16(v[2], v[3]);
                *(LAS u32x2*)(lds + LAT + i * 144 + j0 * 2) = o; }
        }
        __syncthreads();
        {
            bf16x8 aa[2], vb2[TPW][2], sb[TPW][4];
#pragma unroll
            for (int ks = 0; ks < 2; ++ks) { aa[ks] = *(const LAS bf16x8*)(lds + LAT + (mi * 16 + r) * 144 + (ks * 32 + q * 8) * 2);
#pragma unroll
                for (int t = 0; t < TPW; ++t) vb2[t][ks] = *(const LAS bf16x8*)(lb + LVT + ((d0 + t) * 16 + r) * 144 + (ks * 32 + q * 8) * 2); }
#pragma unroll
            for (int ks = 0; ks < 4; ++ks)
#pragma unroll
                for (int t = 0; t < TPW; ++t) sb[t][ks] = *(const LAS bf16x8*)(lds + LST + ((d0 + t) * 16 + r) * 272 + (ks * 32 + q * 8) * 2);
            f32x4 oo[TPW];
#pragma unroll
            for (int t = 0; t < TPW; ++t) oo[t] = (f32x4){0.f, 0.f, 0.f, 0.f};
#pragma unroll
            for (int ks = 0; ks < 4; ++ks)
#pragma unroll
                for (int t = 0; t < TPW; ++t) oo[t] = __builtin_amdgcn_mfma_f32_16x16x32_bf16(sb[t][ks], qa[ks], oo[t], 0, 0, 0);
#pragma unroll
            for (int ks = 0; ks < 2; ++ks)
#pragma unroll
                for (int t = 0; t < TPW; ++t) oo[t] = __builtin_amdgcn_mfma_f32_16x16x32_bf16(vb2[t][ks], aa[ks], oo[t], 0, 0, 0);
#pragma unroll
            for (int t = 0; t < TPW; ++t) { u32x2 o; o[0] = cvt_pk_bf16(oo[t][0], oo[t][1]); o[1] = cvt_pk_bf16(oo[t][2], oo[t][3]);
                *(u32x2*)(O + (tok0 + mi * 16 + r) * 1024 + h * 256 + slice * DVS + (d0 + t) * 16 + q * 4) = o; }
        }
        if (s + 1 < nc) SCAN_WRITE(cur ^ 1);
        __syncthreads();
#pragma unroll
        for (int nd = 0; nd < NDT; ++nd) { acc[nd] = acc[nd] * e4;
            u32x2 o; o[0] = cvt_pk_bf16(acc[nd][0], acc[nd][1]); o[1] = cvt_pk_bf16(acc[nd][2], acc[nd][3]);
            *(LAS u32x2*)(lds + LST + (nd * 16 + r) * 272 + (w * 16 + q * 4) * 2) = o; }
    }
    if (!lat) {
        float* so = p.out + 2 * (size_t)NCTX * D;
#pragma unroll
        for (int nd = 0; nd < NDT; ++nd)
#pragma unroll
            for (int jj = 0; jj < 4; ++jj) { const int kk = w * 16 + q * 4 + jj, dv = nd * 16 + r;
                so[((((size_t)(b * 2 + j) * 2 + dir) * 4 + h) * 128 + kk) * 256 + slice * DVS + dv] = acc[nd][jj]; }
    }
    __syncthreads();
#undef SCAN_LOAD
#undef SCAN_WRITE
}
__device__ void scan_phase(const int g_wid, const Params& p, LAS unsigned char* lds, int j) {
    const int tid_l = LAUNDER_TID(), blk_l = LAUNDER_BLK(); unsigned char* const ws_l = LAUNDER_PTR(p.ws); (void)tid_l; (void)blk_l; (void)ws_l;
    const int tid = tid_l, w = __builtin_amdgcn_readfirstlane(tid >> 6), lane = tid & 63, r = lane & 15, q = lane >> 4;
    unsigned char* S = ws_l + WS_S;
    const int blk = blk_l, G = gridDim.x;
    for (int kq = 0;; ++kq) {
        const int ul = (G == 256) ? (blk < 128 ? (kq == 0 ? blk : 640) : blk + 128 * kq) : blk + kq * G;
        if (ul >= 640) break;
        if (ul < 128) { int u2 = ul; if (G == 256) { const int xcd = ul & 7, jj = ul >> 3; u2 = ((xcd * 2 + (jj >> 3)) << 3) | (jj & 7); }
            const int slice = u2 & 7, dir = (u2 >> 3) & 1, h = (u2 >> 4) & 3, b = u2 >> 6; scan_unit<2>(p, lds, S, j, true, b, h, dir, slice, tid, w, r, q); }
        else { int idx = ul - 128; if (G == 256) { const int kk = idx >> 7, bl = idx & 127, xcd = bl & 7, jj = bl >> 3; idx = ((kk * 32 + xcd * 4 + (jj >> 2)) << 2) | (jj & 3); }
            const int slice = idx & 3, dir = (idx >> 2) & 1, h = (idx >> 3) & 3, b = idx >> 5; scan_unit<4>(p, lds, S, j, false, b, h, dir, slice, tid, w, r, q); }
    }
}

__device__ void onorm_phase(const int g_wid, const Params& p, int j) {
    const int tid_l = LAUNDER_TID(), blk_l = LAUNDER_BLK(); unsigned char* const ws_l = LAUNDER_PTR(p.ws); (void)tid_l; (void)blk_l; (void)ws_l;
    const int lane = tid_l & 63, gw = (blk_l * NT + tid_l) >> 6, nw = (gridDim.x * NT) >> 6;
    unsigned char* S = ws_l + WS_S; const bf16_t* OF = (const bf16_t*)(S + S_OF); const bf16_t* OB = (const bf16_t*)(S + S_OB); const bf16_t* R = (const bf16_t*)(S + S_R);
    bf16_t* H = (bf16_t*)(ws_l + WS_H);
    const f32x4 ng = *(const f32x4*)(p.gla_norm_g + j * 256 + lane * 4);
    for (int it0 = gw; it0 < NTOK * 4; it0 += 4 * nw) {
        u32x2 a[4], b[4], rr[4]; size_t off[4]; bool ok[4];
#pragma unroll
        for (int k = 0; k < 4; ++k) { const int it = it0 + k * nw; ok[k] = it < NTOK * 4; off[k] = (size_t)(ok[k] ? it : 0) * 256 + lane * 4;
            a[k] = *(const u32x2*)(OF + off[k]); b[k] = *(const u32x2*)(OB + off[k]); rr[k] = *(const u32x2*)(R + off[k]); }
#pragma unroll
        for (int k = 0; k < 4; ++k) {
            f32x4 o = {bf_lo(a[k][0]) + bf_lo(b[k][0]), bf_hi(a[k][0]) + bf_hi(b[k][0]), bf_lo(a[k][1]) + bf_lo(b[k][1]), bf_hi(a[k][1]) + bf_hi(b[k][1])};
            float ss = o[0] * o[0] + o[1] * o[1] + o[2] * o[2] + o[3] * o[3];
#pragma unroll
            for (int x = 32; x > 0; x >>= 1) ss += __shfl_xor(ss, x);
            const float rstd = rsqrtf(ss * (1.f / 256.f) + 1e-6f);
            const f32x4 rv = {silu_f(bf_lo(rr[k][0])), silu_f(bf_hi(rr[k][0])), silu_f(bf_lo(rr[k][1])), silu_f(bf_hi(rr[k][1]))};
            const f32x4 y = o * rstd * ng * rv;
            u32x2 out; out[0] = cvt_pk_bf16(y[0], y[1]); out[1] = cvt_pk_bf16(y[2], y[3]); if (ok[k]) *(u32x2*)(H + off[k]) = out;
        }
    }
}

__device__ void convact_phase(const int g_wid, const Params& p, int layer) {
    const int tid_l = LAUNDER_TID(), blk_l = LAUNDER_BLK(); unsigned char* const ws_l = LAUNDER_PTR(p.ws); (void)tid_l; (void)blk_l; (void)ws_l;
    unsigned char* S = ws_l + WS_S; const bf16_t* A = (const bf16_t*)(S + S_UPA); const bf16_t* Gt = (const bf16_t*)(S + S_UPG); bf16_t* ACT = (bf16_t*)(S + S_ACT);
    const float* cw = p.ffn_conv_w + (size_t)layer * 3 * FFN; const float* cb = p.ffn_conv_b + (size_t)layer * FFN;
    const size_t gt = (size_t)blk_l * NT + tid_l, gs = (size_t)gridDim.x * NT;
    for (size_t it = gt; it < (size_t)512 * 352; it += gs) {
        const int seg = (int)(it / 352), c0 = (int)(it % 352) * 8, tok0 = seg * 16;
        const int lenm1 = tok0 < NCTX ? 255 : 63;
        f32x4 w0[2], w1[2], w2[2], bb[2];
#pragma unroll
        for (int h2 = 0; h2 < 2; ++h2) { w0[h2] = *(const f32x4*)(cw + c0 + 4 * h2); w1[h2] = *(const f32x4*)(cw + FFN + c0 + 4 * h2); w2[h2] = *(const f32x4*)(cw + 2 * FFN + c0 + 4 * h2); bb[h2] = *(const f32x4*)(cb + c0 + 4 * h2); }
        const u32x4 z = {0u, 0u, 0u, 0u};
        size_t off = (size_t)tok0 * FFN + c0;
        u32x4 prev = (tok0 & lenm1) > 0 ? *(const u32x4*)(A + off - FFN) : z, cur = *(const u32x4*)(A + off);
#pragma unroll 4
        for (int t = 0; t < 16; ++t, off += FFN) {
            const int pos = (tok0 + t) & lenm1;
            const u32x4 nxt = pos < lenm1 ? *(const u32x4*)(A + off + FFN) : z, gg = *(const u32x4*)(Gt + off);
            u32x4 o;
#pragma unroll
            for (int e = 0; e < 4; ++e) { const int h2 = e >> 1, x = (e & 1) * 2;
                const float v0 = bf_lo(prev[e]) * w0[h2][x] + bf_lo(cur[e]) * w1[h2][x] + bf_lo(nxt[e]) * w2[h2][x] + bb[h2][x];
                const float v1 = bf_hi(prev[e]) * w0[h2][x + 1] + bf_hi(cur[e]) * w1[h2][x + 1] + bf_hi(nxt[e]) * w2[h2][x + 1] + bb[h2][x + 1];
                o[e] = cvt_pk_bf16(silu_f(v0) * bf_lo(gg[e]), silu_f(v1) * bf_hi(gg[e])); }
            *(u32x4*)(ACT + off) = o;
            prev = cur; cur = nxt;
        }
    }
}

constexpr int N_PHASES = 1 + 11 + 6 + 9 + 6 + 1;
__device__ __forceinline__ void decode_phase(int ph, int& layer, int& kind) {
    if (ph == 0) { layer = 0; kind = 0; return; }
    ph -= 1;
    if (ph < 11) { layer = 0; kind = ph == 0 ? 10 : ph == 1 ? 11 : ph == 2 ? 1 : ph <= 6 ? 9 + ph : ph == 7 ? 30 : ph == 8 ? 31 : ph == 9 ? 2 : 33; return; }
    if (ph < 17) { layer = 1; ph -= 11; } else if (ph < 26) { layer = 2; ph -= 17; } else if (ph < 32) { layer = 3; ph -= 26; } else { layer = 4; kind = 40; return; }
    if ((layer & 1) == 0) kind = ph < 6 ? 10 + ph : (ph == 6 ? 30 : ph == 7 ? 31 : 33);
    else kind = ph == 0 ? 10 : (ph < 3 ? 19 + ph : (ph == 3 ? 30 : ph == 4 ? 31 : 33));
}

__global__ void __launch_bounds__(NT, 2) fwd_kernel(Params p) {
    extern __shared__ __attribute__((aligned(16))) unsigned char shm[];
    LAS unsigned char* lds = (LAS unsigned char*)shm;
    const int tid = threadIdx.x, G = gridDim.x; const int g_wid = __builtin_amdgcn_readfirstlane(tid >> 6);
    volatile LAS unsigned* st = (volatile LAS unsigned*)(lds + LDS_TOP);
    if (tid < 4) st[tid] = 0u;
    __syncthreads();
    XcdBarrier bar; bar.bar = (unsigned*)(p.ws + WS_CTL); bar.x = 0; bar.st = st;
    const bool multi = (p.ph_hi - p.ph_lo) > 1;
    if (multi) bar = xcd_barrier_post((unsigned*)(p.ws + WS_CTL), st);
    if (p.never) cg::this_grid().sync();
    int repdone = 0; (void)repdone;
    for (int ph = p.ph_lo; ph < p.ph_hi; ++ph) {
        int layer, kind; decode_phase(ph, layer, kind);
        unsigned char* const ws = LAUNDER_PTR(p.ws); unsigned char* const S = ws + WS_S; const int c = LAUNDER_BLK();
        const int j = layer >> 1;
        const float* MODV = (const float*)(ws + WS_MODV); const float* mv = MODV + (size_t)layer * 3 * 6144;
        bool is_gemm = true; GSched Sd{}; Sd.G = G; Sd.c = c; Sd.lda = 2048; Sd.ldb = 2048;
        switch (kind) {
        case 1: Sd.c = G - 1 - c; Sd.kind = 4; Sd.A = (const char*)(ws + WS_WINB); Sd.B = (const char*)(ws + WS_CW); Sd.ldb = 512; Sd.nt = 4; Sd.o0 = (bf16_t*)(ws + WS_T1); break;
        case 2: Sd.c = G - 1 - c; Sd.kind = 5; Sd.A = (const char*)(ws + WS_WOT); Sd.B = (const char*)(ws + WS_T1); Sd.nt = 16; Sd.o0 = (bf16_t*)(ws + WS_WCS); break;
        case 11: Sd.kind = 0; Sd.A = (const char*)(ws + WS_H); Sd.B = (const char*)(ws + WS_WGIN) + (size_t)j * GINP * 2048; Sd.nM = 32; Sd.nN = 13; Sd.nt = 16; Sd.o0 = (bf16_t*)S; break;
        case 15: Sd.kind = 3; Sd.A = (const char*)(ws + WS_H); Sd.B = (const char*)(ws + WS_WGO) + (size_t)j * 2 * MB; Sd.nt = 8; Sd.koff = 1024; Sd.o0 = (bf16_t*)(S + S_PART); break;
        case 20: Sd.kind = 2; Sd.A = (const char*)(ws + WS_WCS) + (size_t)j * 4 * MB; Sd.B = (const char*)(ws + WS_H); Sd.nM = 8; Sd.nN = 32; Sd.nt = 16;
            Sd.o0 = (bf16_t*)(S + S_HWTC); Sd.o1 = (bf16_t*)(S + S_HWTL); break;
        case 21: Sd.kind = 6; Sd.A = (const char*)(ws + WS_DL2048); Sd.B = (const char*)(S + S_HWTL); Sd.A2 = (const char*)(ws + WS_DL256); Sd.B2 = (const char*)(S + S_HWTC); Sd.lda = 8192; Sd.ldb = 16384;
            Sd.o0 = (bf16_t*)(S + S_PART); break;
        case 31: Sd.kind = 1; Sd.A = (const char*)(ws + WS_H); Sd.B = (const char*)(ws + WS_WUP) + (size_t)layer * 2 * FFN * 2048; Sd.nM = 32; Sd.nN = 22; Sd.nt = 16;
            Sd.o0 = (bf16_t*)(S + S_ACT); Sd.cw = p.ffn_conv_w + (size_t)layer * 3 * FFN; Sd.cb = p.ffn_conv_b + (size_t)layer * FFN; break;
        case 33: Sd.kind = 3; Sd.A = (const char*)(S + S_ACT); Sd.B = (const char*)(ws + WS_WDN) + (size_t)layer * 1024 * FFN * 2; Sd.lda = FFN * 2; Sd.ldb = FFN * 2; Sd.nt = 22; Sd.koff = 1408 * 2;
            Sd.o0 = (bf16_t*)(S + S_PART); break;
        default: is_gemm = false; break;
        }
        if (is_gemm) pg8::gemm_phase(g_wid, lds, Sd.lda, Sd.ldb, Sd);
        else switch (kind) {
        case 0: setup_phase(g_wid, p, lds); break;
        case 10:
            if (layer == 0) norm_phase<false>(g_wid, p, p.x_prompt, p.x_sample, nullptr, 0, 0, p.norm_mix_g, mv + 0, mv + 1024);
            else norm_phase<false>(g_wid, p, nullptr, nullptr, MODV + (size_t)(layer - 1) * 3 * 6144 + 5 * 1024, 2, 2, p.norm_mix_g + layer * 1024, mv + 0, mv + 1024);
            break;
        case 12: gate_phase(g_wid, p, lds, j); break;
        case 13: scan_phase(g_wid, p, lds, j); break;
        case 14: onorm_phase(g_wid, p, j); break;
        case 30: { const bool gla = (layer & 1) == 0;
            norm_phase<false>(g_wid, p, layer == 0 ? p.x_prompt : nullptr, layer == 0 ? p.x_sample : nullptr, mv + 2 * 1024, 2, gla ? 2 : 4, p.norm_ffn_g + layer * 1024, mv + 3 * 1024, mv + 4 * 1024); } break;
        case 40: norm_phase<true>(g_wid, p, nullptr, nullptr, MODV + (size_t)3 * 3 * 6144 + 5 * 1024, 2, 2, p.final_norm_g, nullptr, nullptr); break;
        default: break;
        }
        if (ph + 1 < p.ph_hi && ph != 2 && ph != 9) xcd_barrier(g_wid, bar);
#if REP_MASK
        if (!repdone && (((REP_MASK & 1) && is_gemm) || ((REP_MASK & 2) && kind == 13) || ((REP_MASK & 4) && kind == 0) || ((REP_MASK & 8) && (kind == 12 || kind == 14 || kind == 32)) || ((REP_MASK & 16) && kind == 12) || ((REP_MASK & 32) && kind == 14) || ((REP_MASK & 64) && kind == 32) || ((REP_MASK & 128) && kind == 33) || ((REP_MASK & 256) && kind == 31) || ((REP_MASK & 512) && kind == 11))) { repdone = 1; --ph; } else repdone = 0;
#endif
    }
}


#ifdef DBG_STOP
struct DbgBuf { size_t off; size_t n; int f32; int inS; };
__global__ void dbg_check(Params p, unsigned* flag) {
    const DbgBuf bufs[] = { {S_OF, 4194304, 0, 1} };
    const int nb = sizeof(bufs) / sizeof(bufs[0]);
    const size_t gt = (size_t)blockIdx.x * blockDim.x + threadIdx.x, gs = (size_t)gridDim.x * blockDim.x;
    for (int b = 0; b < nb && b < DBG_NBUF; ++b) {
        const unsigned char* base = p.ws + (bufs[b].inS ? WS_S : 0) + bufs[b].off; bool bad = false;
        if (bufs[b].f32) { const unsigned* q = (const unsigned*)base; for (size_t i = gt; i < bufs[b].n; i += gs) { const unsigned v = q[i]; if (v == 0xAAAAAAAAu) bad = true; } }
        else { const unsigned short* q = (const unsigned short*)base; unsigned cnt = 0; for (size_t i = gt; i < bufs[b].n; i += gs) { const unsigned short v = q[i]; if (v == 0xAAAAu) ++cnt; } if (cnt) atomicAdd(flag, cnt); }


    }
}
__global__ void dbg_fill(float* out, const unsigned* flag, size_t n_all, size_t n_first) {
    const unsigned f = *flag; const float c1 = 2.f * floorf(log2f(1.f + (float)f)), c2 = c1;
    for (size_t i = (size_t)blockIdx.x * blockDim.x + threadIdx.x; i < n_all; i += (size_t)gridDim.x * blockDim.x) out[i] = i < n_first / 2 ? c1 : (i < n_first ? c2 : 0.f);
}
#endif

extern "C" void kernel_launch(void* const* d_in, const int* in_sizes, int n_in, void* d_out, int out_size, void* d_ws, size_t ws_size, hipStream_t stream) {
    static int grid = 0;
    if (grid == 0) {
        if (n_in != 21 || ws_size < WS_END) { fprintf(stderr, "kernel_launch: unexpected n_in %d or ws_size %zu (< %zu)\n", n_in, ws_size, (size_t)WS_END); grid = -1; return; }
        int dev = 0, cus = 0, per_cu = 0;
        hipGetDevice(&dev); hipDeviceGetAttribute(&cus, hipDeviceAttributeMultiprocessorCount, dev);
        if (hipFuncSetAttribute((const void*)fwd_kernel, hipFuncAttributeMaxDynamicSharedMemorySize, LDS_BYTES) != hipSuccess) { fprintf(stderr, "kernel_launch: hipFuncSetAttribute failed\n"); grid = -1; return; }
        hipOccupancyMaxActiveBlocksPerMultiprocessor(&per_cu, (const void*)fwd_kernel, NT, LDS_BYTES);
        if (per_cu < 1) { fprintf(stderr, "kernel_launch: occupancy query says %d\n", per_cu); per_cu = 1; }
        (void)hipGetLastError();
        grid = cus;
    }
    if (grid < 0) return;
    Params p{};
    const float** pp = (const float**)&p;
    for (int i = 0; i < 21; ++i) pp[i] = (const float*)d_in[i];
    p.out = (float*)d_out; p.ws = (unsigned char*)d_ws; p.never = 0; p.pad = 0;
    hipMemsetAsync((char*)d_ws + WS_CTL, 0, 16384, stream);
#if ONE_LAUNCH
    p.ph_lo = 0; p.ph_hi = N_PHASES;
    void* args[] = {&p};
    hipError_t e = hipLaunchCooperativeKernel((const void*)fwd_kernel, dim3(grid), dim3(NT), args, LDS_BYTES, stream);
    if (e != hipSuccess) fprintf(stderr, "cooperative launch failed: %s (grid %d)\n", hipGetErrorString(e), grid);
#else
#ifdef DBG_STOP
    for (int ph = 0; ph < DBG_STOP; ++ph) { p.ph_lo = ph; p.ph_hi = ph + 1; hipLaunchKernelGGL(fwd_kernel, dim3(grid), dim3(NT), LDS_BYTES, stream, p); }

    unsigned* flag = (unsigned*)((char*)d_ws + WS_CTL + 15360);
    hipMemsetAsync(flag, 0, 4, stream);
    hipLaunchKernelGGL(dbg_check, dim3(1024), dim3(256), 0, stream, p, flag);
    hipLaunchKernelGGL(dbg_fill, dim3(1024), dim3(256), 0, stream, (float*)d_out, flag, (size_t)out_size, (size_t)NCTX * D);
#else
    for (int ph = 0; ph < N_PHASES; ++ph) { p.ph_lo = ph; p.ph_hi = ph + 1; hipLaunchKernelGGL(fwd_kernel, dim3(grid), dim3(NT), LDS_BYTES, stream, p); }
#endif
#endif
}
```
